# Optimizing an MI355X kernel written in HIP

```python
import math
import jax, jax.numpy as jnp
from jax import lax
import numpy as np

D_MODEL = 2048
BATCH = 1
SEQ = 8192
DEPTH = 4
DEC_BATCH = 8
DEC_SEQ = 64
PAST_LEN = 1024

CHUNK = 64
N_MIXERS = 2
N_RET = (DEPTH + 1) // 2
N_SSM = DEPTH // 2
RET_HEADS = 8
RET_DK = D_MODEL // RET_HEADS
RET_DV = 2 * RET_DK
RET_QK = RET_HEADS * RET_DK
RET_VD = RET_HEADS * RET_DV
ROPE_BASE = 10000.0
SSM_GROUP = 16
SSM_GROUPS = D_MODEL // SSM_GROUP
SSM_STATE = 64
DT_MIN = 0.001
DT_MAX = 0.1
FFN_DIM = 2 * D_MODEL
CONV_W = 3
EPS = 1e-6

kernel_name = 'retnet_s5_streaming_hybrid_step'

F32 = jnp.float32


def rmsnorm(x, g):
    xf = x.astype(F32)
    y = xf * lax.rsqrt(jnp.mean(xf * xf, axis=-1, keepdims=True) + EPS)
    return (y * g.astype(F32)).astype(x.dtype)


def rotary(x, pos):
    half = RET_DK // 2
    inv = ROPE_BASE ** (-jnp.arange(half, dtype=F32) / half)
    ang = pos.astype(F32)[:, None] * inv[None, :]
    cos = jnp.cos(ang)[None, :, None, :]
    sin = jnp.sin(ang)[None, :, None, :]
    x1, x2 = x[..., :half], x[..., half:]
    return jnp.concatenate([x1 * cos - x2 * sin, x1 * sin + x2 * cos], axis=-1)


def retention_block(S, q, k, v, log_g):
    L = q.shape[1]
    idx = jnp.arange(L, dtype=F32)
    dist = jnp.abs(idx[:, None] - idx[None, :])
    intra = jnp.exp(dist[None] * log_g[:, None, None])
    scores = jnp.einsum('blhd,bmhd->bhlm', q, k) * intra[None]
    out = jnp.einsum('bhlm,bmhe->blhe', scores, v)
    cross = jnp.exp((idx + 1.0)[:, None] * log_g[None, :])
    out = out + jnp.einsum('blhd,bhde->blhe', q, S) * cross[None, :, :, None]
    k_dec = jnp.exp((L - 1.0 - idx)[:, None] * log_g[None, :])
    S_new = jnp.exp(L * log_g)[None, :, None, None] * S + jnp.einsum(
        'blhd,blhe->bhde', k * k_dec[None, :, :, None], v)
    return S_new, out


def to_blocks(t, nb, blk):
    B = t.shape[0]
    return jnp.moveaxis(t.reshape((B, nb, blk) + t.shape[2:]), 1, 0)


def from_blocks(t):
    t = jnp.moveaxis(t, 0, 1)
    return t.reshape((t.shape[0], t.shape[1] * t.shape[2]) + t.shape[3:])


def retention_mixer(h, S0, pos, w_in, gn, w_out):
    B, L, _ = h.shape
    proj = h @ w_in
    q, k, v, g = jnp.split(proj, [RET_QK, 2 * RET_QK, 2 * RET_QK + RET_VD], axis=-1)
    q = rotary(q.reshape(B, L, RET_HEADS, RET_DK).astype(F32), pos)
    k = rotary(k.reshape(B, L, RET_HEADS, RET_DK).astype(F32), pos) * (RET_DK ** -0.5)
    v = v.reshape(B, L, RET_HEADS, RET_DV).astype(F32)
    log_g = jnp.log1p(-jnp.exp2(-5.0 - jnp.arange(RET_HEADS, dtype=F32)))
    blk = min(L, CHUNK)
    nb = L // blk
    S_last, o = lax.scan(lambda S, xs: retention_block(S, xs[0], xs[1], xs[2], log_g),
                         S0.astype(F32), (to_blocks(q, nb, blk), to_blocks(k, nb, blk), to_blocks(v, nb, blk)))
    o = from_blocks(o)
    mu = jnp.mean(o, axis=-1, keepdims=True)
    var = jnp.mean(jnp.square(o - mu), axis=-1, keepdims=True)
    o = ((o - mu) * lax.rsqrt(var + EPS)).reshape(B, L, RET_VD) * gn.astype(F32)
    y = (o.astype(h.dtype) * jax.nn.silu(g)) @ w_out
    return y, S_last


def _ssm_combine(left, right):
    a1, b1 = left
    a2, b2 = right
    return a1 * a2, a2 * b1 + b2


def ssm_block(h0, u, A_bar, B_bar, C):
    bu = jnp.einsum('gpc,blgc->blgp', B_bar, u.astype(jnp.complex64))
    bu = bu.at[:, 0].add(A_bar[None] * h0)
    a = jnp.broadcast_to(A_bar, bu.shape)
    _, hs = lax.associative_scan(_ssm_combine, (a, bu), axis=1)
    y = jnp.einsum('gcp,blgp->blgc', C, hs).real
    return hs[:, -1], y


def ssm_mixer(h, h0, a_re, a_im, log_dt, b_re, b_im, c_re, c_im, d, w_glu):
    B, L, _ = h.shape
    A = lax.complex(a_re.astype(F32), a_im.astype(F32))
    dt = jnp.exp(log_dt.astype(F32))[:, None]
    A_bar = jnp.exp(A * dt)
    B_bar = ((A_bar - 1.0) / A)[..., None] * lax.complex(b_re.astype(F32), b_im.astype(F32))
    C = lax.complex(c_re.astype(F32), c_im.astype(F32))
    hf = h.astype(F32)
    u = hf.reshape(B, L, SSM_GROUPS, SSM_GROUP)
    blk = min(L, CHUNK)
    nb = L // blk
    h_last, y = lax.scan(lambda s, ub: ssm_block(s, ub, A_bar, B_bar, C), h0, to_blocks(u, nb, blk))
    y = from_blocks(y).reshape(B, L, D_MODEL) + d.astype(F32) * hf
    gl = jax.nn.gelu(y).astype(h.dtype)
    ga, gb = jnp.split(gl @ w_glu, 2, axis=-1)
    return ga * jax.nn.sigmoid(gb), h_last


def conv_ffn(h, prev, w_up, conv_w, conv_b, w_down):
    L = h.shape[1]
    a, b = jnp.split(h @ w_up, 2, axis=-1)
    a_pad = jnp.concatenate([prev.astype(a.dtype), a], axis=1)
    conv = conv_b
    for j in range(CONV_W):
        conv = conv + conv_w[j] * a_pad[:, j:j + L]
    y = (jax.nn.silu(conv) * b) @ w_down
    return y, a_pad[:, L:]


def setup_inputs(seed: int = 0) -> dict:
    key = jax.random.key(seed)
    ks = jax.random.split(key, 32)
    D, G, P = D_MODEL, SSM_GROUPS, SSM_STATE

    def nrm(k, shape, s):
        return jax.random.normal(k, shape, F32) * s

    return {
        'x_prompt': nrm(ks[0], (BATCH, SEQ, D), 1.0),
        'x_sample': nrm(ks[1], (DEC_BATCH, DEC_SEQ, D), 1.0),
        'state_ret': nrm(ks[2], (N_RET, DEC_BATCH, RET_HEADS, RET_DK, RET_DV), 0.05),
        'state_ssm_re': nrm(ks[3], (N_SSM, DEC_BATCH, G, P), 0.5),
        'state_ssm_im': nrm(ks[4], (N_SSM, DEC_BATCH, G, P), 0.5),
        'cache_conv': nrm(ks[5], (DEPTH, DEC_BATCH, CONV_W - 1, FFN_DIM), 1.0),
        'norm_mix': 1.0 + nrm(ks[6], (DEPTH, D), 0.01),
        'norm_ffn': 1.0 + nrm(ks[7], (DEPTH, D), 0.01),
        'norm_final': 1.0 + nrm(ks[8], (D,), 0.01),
        'ret_w_in': nrm(ks[9], (N_RET, D, 2 * RET_QK + 2 * RET_VD), D ** -0.5),
        'ret_gn': 1.0 + nrm(ks[10], (N_RET, RET_VD), 0.01),
        'ret_w_out': nrm(ks[11], (N_RET, RET_VD, D), RET_VD ** -0.5),
        'ssm_a_re': -0.5 + nrm(ks[12], (N_SSM, G, P), 0.01),
        'ssm_a_im': math.pi * jnp.arange(P, dtype=F32) + nrm(ks[13], (N_SSM, G, P), 0.01),
        'ssm_log_dt': jax.random.uniform(ks[14], (N_SSM, G), F32, math.log(DT_MIN), math.log(DT_MAX)),
        'ssm_b_re': nrm(ks[15], (N_SSM, G, P, SSM_GROUP), (2 * SSM_GROUP) ** -0.5),
        'ssm_b_im': nrm(ks[16], (N_SSM, G, P, SSM_GROUP), (2 * SSM_GROUP) ** -0.5),
        'ssm_c_re': nrm(ks[17], (N_SSM, G, SSM_GROUP, P), P ** -0.5),
        'ssm_c_im': nrm(ks[18], (N_SSM, G, SSM_GROUP, P), P ** -0.5),
        'ssm_d': nrm(ks[19], (N_SSM, D), 1.0),
        'ssm_w_glu': nrm(ks[20], (N_SSM, D, 2 * D), D ** -0.5),
        'ffn_w_up': nrm(ks[21], (DEPTH, D, 2 * FFN_DIM), D ** -0.5),
        'ffn_conv_w': nrm(ks[22], (DEPTH, CONV_W, FFN_DIM), CONV_W ** -0.5),
        'ffn_conv_b': nrm(ks[23], (DEPTH, FFN_DIM), 0.01),
        'ffn_w_down': nrm(ks[24], (DEPTH, FFN_DIM, D), FFN_DIM ** -0.5),
    }


def reference(x_prompt, x_sample, state_ret, state_ssm_re, state_ssm_im, cache_conv,
              norm_mix, norm_ffn, norm_final, ret_w_in, ret_gn, ret_w_out,
              ssm_a_re, ssm_a_im, ssm_log_dt, ssm_b_re, ssm_b_im, ssm_c_re, ssm_c_im, ssm_d, ssm_w_glu,
              ffn_w_up, ffn_conv_w, ffn_conv_b, ffn_w_down):

    def run_trunk(x, pos, s_ret, s_re, s_im, c_conv):
        new_ret, new_re, new_im, new_conv = [], [], [], []
        for i in range(DEPTH):
            j = i // N_MIXERS
            h = rmsnorm(x, norm_mix[i])
            if i % N_MIXERS == 0:
                y, s = retention_mixer(h, s_ret[j], pos, ret_w_in[j], ret_gn[j], ret_w_out[j])
                new_ret.append(s)
            else:
                h0 = lax.complex(s_re[j].astype(F32), s_im[j].astype(F32))
                y, s = ssm_mixer(h, h0, ssm_a_re[j], ssm_a_im[j], ssm_log_dt[j], ssm_b_re[j], ssm_b_im[j],
                                 ssm_c_re[j], ssm_c_im[j], ssm_d[j], ssm_w_glu[j])
                new_re.append(s.real)
                new_im.append(s.imag)
            x = x + y.astype(x.dtype)
            y, c = conv_ffn(rmsnorm(x, norm_ffn[i]), c_conv[i], ffn_w_up[i], ffn_conv_w[i],
                            ffn_conv_b[i], ffn_w_down[i])
            new_conv.append(c)
            x = x + y.astype(x.dtype)
        return (rmsnorm(x, norm_final), jnp.stack(new_ret), jnp.stack(new_re),
                jnp.stack(new_im), jnp.stack(new_conv))

    Bp, Lp, _ = x_prompt.shape
    pos_p = jnp.arange(Lp, dtype=jnp.int32)
    zr = jnp.zeros((N_RET, Bp, RET_HEADS, RET_DK, RET_DV), F32)
    zs = jnp.zeros((N_SSM, Bp, SSM_GROUPS, SSM_STATE), F32)
    zc = jnp.zeros((DEPTH, Bp, CONV_W - 1, FFN_DIM), x_prompt.dtype)
    y_prompt, ret_p, re_p, im_p, conv_p = run_trunk(x_prompt, pos_p, zr, zs, zs, zc)

    Ls = x_sample.shape[1]
    pos_s = PAST_LEN + jnp.arange(Ls, dtype=jnp.int32)
    y_sample, ret_s, re_s, im_s, conv_s = run_trunk(x_sample, pos_s, state_ret, state_ssm_re,
                                                    state_ssm_im, cache_conv)
    return (y_prompt, y_sample, ret_p, ret_s, re_p, im_p, re_s, im_s, conv_p, conv_s)
```

```cpp
#include <hip/hip_runtime.h>
#include <hip/hip_cooperative_groups.h>
#include <cstdio>
#include <cstdint>
namespace cg = cooperative_groups;
namespace pg8 {
#define PG8_LAS __attribute__((address_space(3)))
typedef unsigned short bf16_t;
typedef short bf16x8 __attribute__((ext_vector_type(8)));
typedef float f32x4 __attribute__((ext_vector_type(4)));
typedef unsigned u32x4 __attribute__((ext_vector_type(4)));
constexpr int BM = 256, BK = 64, HALF = 128, HTB = HALF * BK * 2  , STAGE_BYTES = 8 * HTB, NXCD = 8, WGM = 8;

__host__ __device__ __forceinline__ int lds_byte(int r, int c) { const int st = (r >> 4) * 2 + (c >> 5), rr = r & 15, cc = c & 31, ob = rr * 64 + cc * 2; return st * 1024 + (ob ^ (((ob >> 9) & 1) << 5)); }
__host__ __device__ __forceinline__ void stage_rc(int b, int& R, int& C) { const int st = b / 1024, sb = b % 1024, swz = sb ^ (((sb >> 9) & 1) << 5); R = (st >> 1) * 16 + swz / 64; C = (st & 1) * 32 + (swz % 64) / 2; }
__host__ __device__ __forceinline__ int perm32(int rho) { const int n = rho >> 4, i = rho & 15; return 8 * (i >> 2) + 4 * n + (i & 3); }

struct Unit { int pm, pn, koff, nt; };
struct Gemm { const bf16_t* A; const bf16_t* Bt; int M, N, K; };

struct StaticOrder {
    int nM, nN, nwg, G, c, nt0;
    __host__ __device__ void init(int M, int N, int G_, int c_, int K_) { nM = M / BM; nN = N / BM; nwg = nM * nN; G = G_; c = c_; nt0 = K_ / BK; }
    __host__ __device__ bool next(int i, Unit& u) const {
        const long L = (long)i * G + c; if (L >= nwg) return false;
        int wgid = (int)L; { const int q = nwg / NXCD, r = nwg % NXCD, xcd = wgid % NXCD, off = wgid / NXCD; wgid = (xcd < r ? xcd * (q + 1) : r * (q + 1) + (xcd - r) * q) + off; }
        const int nig = WGM * nN, gid = wgid / nig, fm = gid * WGM, gsz = (nM - fm) < WGM ? (nM - fm) : WGM;
        u.pm = fm + ((wgid % nig) % gsz); u.pn = (wgid % nig) / gsz; u.koff = 0; u.nt = nt0; return true;
    }
    __device__ __forceinline__ void a_ready(const Unit&) const {}
    __device__ __forceinline__ void done(const Unit&) const {}
};
struct ResOrder {
    StaticOrder so; int G, c;
    __host__ __device__ void init(int G_, int c_) { so.init(8192, 2048, G_, c_, 4096); G = G_; c = c_; }
    __host__ __device__ bool next(int i, Unit& u) const {
        const int L = i * G + c; if (L >= 512) return false;
        if (L < 256) return so.next(i, u);
        const int s2 = L - 256, tile = s2 >> 4, sl = s2 & 15; u.pm = 32 + (tile >> 3); u.pn = tile & 7; u.koff = sl * 512; u.nt = 4; return true;
    }
    __device__ __forceinline__ void a_ready(const Unit&) const {}
    __device__ __forceinline__ void done(const Unit&) const {}
};
__device__ __forceinline__ unsigned cvt_pk_bf16(float lo, float hi) { unsigned r; asm volatile("v_cvt_pk_bf16_f32 %0, %1, %2" : "=v"(r) : "v"(lo), "v"(hi)); return r; }
typedef float f32x2 __attribute__((ext_vector_type(2)));
template <class Epi, class Sched, bool ALIGN_EPI = false, bool SP2 = false>
__device__ __forceinline__ void gemm_phase(PG8_LAS unsigned char* lds, const Gemm g, const Sched& S, const Epi& E) {
    int tid = threadIdx.x; asm volatile("" : "+v"(tid)); const int wid = __builtin_amdgcn_readfirstlane(tid >> 6), lane = tid & 63, wr = wid >> 2, wc = wid & 3, fr = lane & 15, fq = lane >> 4;
    const int K = g.K;
    unsigned voffA[2], voffB[2];
#pragma unroll
    for (int i = 0; i < 2; ++i) { int R, C; stage_rc(tid * 16 + i * 8192, R, C); const int Rb = Epi::PERM ? ((R & ~31) + perm32(R & 31)) : R;
        voffA[i] = (unsigned)(R * K + C) * 2u; voffB[i] = (unsigned)(Rb * K + C) * 2u; }
    const size_t kstep = (size_t)(BK * 2);
    const size_t hstep = (size_t)HALF * K * 2;
    const size_t tstep = 2 * hstep;
    const unsigned ldsw = (unsigned)wid * 1024u;
    const int aoff = lds_byte(wr * 64 + fr, fq * 8), boff = lds_byte(wc * 32 + fr, fq * 8);
#define PG8_SA(b, h) (((b) * 2 + (h)) * HTB)
#define PG8_SB(b, h) ((4 + (b) * 2 + (h)) * HTB)
#define PG8_STAGE(bufoff, gbase, voff) do { _Pragma("unroll") for (int _i = 0; _i < 2; ++_i) \
        __builtin_amdgcn_global_load_lds((const unsigned*)((const char*)(gbase) + (voff)[_i]), (PG8_LAS unsigned*)(lds + (bufoff) + ldsw + _i * 8192), 16, 0, 0); } while (0)
#define PG8_LDA(dst, b, h) do { _Pragma("unroll") for (int m = 0; m < 4; ++m) _Pragma("unroll") for (int k = 0; k < 2; ++k) dst[m][k] = *(const PG8_LAS bf16x8*)(lds + PG8_SA(b, h) + aoff + m * 2048 + k * 1024); } while (0)
#define PG8_LDB(dst, b, h) do { _Pragma("unroll") for (int n = 0; n < 2; ++n) _Pragma("unroll") for (int k = 0; k < 2; ++k) dst[n][k] = *(const PG8_LAS bf16x8*)(lds + PG8_SB(b, h) + boff + n * 2048 + k * 1024); } while (0)
#define PG8_MMA(ai, bj, At, Bt) do { __builtin_amdgcn_s_setprio(1); _Pragma("unroll") for (int m = 0; m < 4; ++m) _Pragma("unroll") for (int n = 0; n < 2; ++n) _Pragma("unroll") for (int k = 0; k < 2; ++k) \
        acc[ai][bj][m][n] = __builtin_amdgcn_mfma_f32_16x16x32_bf16(Bt[n][k], At[m][k], acc[ai][bj][m][n], 0, 0, 0); __builtin_amdgcn_s_setprio(0); } while (0)
#define PG8_WAIT_V(n) asm volatile("s_waitcnt vmcnt(" #n ")" ::: "memory")
#define PG8_WAIT_L(n) asm volatile("s_waitcnt lgkmcnt(" #n ")" ::: "memory")
#define PG8_BAR __builtin_amdgcn_s_barrier()
#define PG8_SCHED __builtin_amdgcn_sched_barrier(0)
    Unit cur, nxt; int ui = 0;
    if (!S.next(0, cur)) return;
    f32x4 acc[2][2][4][2];
#pragma unroll
    for (int a = 0; a < 2; ++a)
#pragma unroll
        for (int b = 0; b < 2; ++b)
#pragma unroll
            for (int m = 0; m < 4; ++m)
#pragma unroll
                for (int n = 0; n < 2; ++n) acc[a][b][m][n] = (f32x4){0.f, 0.f, 0.f, 0.f};
    bf16x8 At[4][2], B0[2][2], B1[2][2];
    const char* cA = (const char*)g.A + (size_t)cur.pm * tstep + cur.koff; const char* cB = (const char*)g.Bt + (size_t)cur.pn * tstep + cur.koff;
    S.a_ready(cur);
    if constexpr (SP2) {
        PG8_STAGE(PG8_SB(0, 0), cB, voffB); PG8_STAGE(PG8_SB(0, 1), cB + hstep, voffB); PG8_STAGE(PG8_SA(0, 0), cA, voffA); PG8_STAGE(PG8_SA(0, 1), cA + hstep, voffA);
        if (wr == 1) PG8_BAR;
        PG8_WAIT_V(2); PG8_BAR;
        PG8_STAGE(PG8_SB(1, 0), cB + kstep, voffB); PG8_STAGE(PG8_SA(1, 0), cA + kstep, voffA); PG8_STAGE(PG8_SB(1, 1), cB + hstep + kstep, voffB);
        PG8_WAIT_V(6); PG8_BAR;
    } else {
        PG8_STAGE(PG8_SB(0, 0), cB, voffB); PG8_STAGE(PG8_SA(0, 0), cA, voffA); PG8_STAGE(PG8_SB(0, 1), cB + hstep, voffB); PG8_STAGE(PG8_SA(0, 1), cA + hstep, voffA);
        if (wr == 1) PG8_BAR;
        PG8_WAIT_V(4); PG8_BAR;
        PG8_STAGE(PG8_SB(1, 0), cB + kstep, voffB); PG8_STAGE(PG8_SA(1, 0), cA + kstep, voffA); PG8_STAGE(PG8_SB(1, 1), cB + hstep + kstep, voffB);
        PG8_WAIT_V(6); PG8_BAR;
    }
    for (;;) {
        const bool has_next = S.next(ui + 1, nxt);
        const char* nA = has_next ? (const char*)g.A + (size_t)nxt.pm * tstep + nxt.koff : cA; const char* nB = has_next ? (const char*)g.Bt + (size_t)nxt.pn * tstep + nxt.koff : cB;
        const int nt = cur.nt;
        for (int t = 0; t < nt; t += 2) {
            const bool last = (t == nt - 2);
            const char* a1 = cA + (size_t)(t + 1) * kstep;
            const char* a2 = last ? nA : cA + (size_t)(t + 2) * kstep; const char* b2 = last ? nB : cB + (size_t)(t + 2) * kstep;
            const char* a3 = a2 + kstep; const char* b3 = b2 + kstep;
            if (last && has_next) S.a_ready(nxt);
            if constexpr (SP2) {
            PG8_LDB(B0, 0, 0); PG8_LDB(B1, 0, 1); PG8_SCHED; PG8_LDA(At, 0, 0); PG8_STAGE(PG8_SA(1, 1), a1 + hstep, voffA);
            PG8_WAIT_V(8); PG8_WAIT_L(0); PG8_BAR; PG8_MMA(0, 0, At, B0); PG8_MMA(0, 1, At, B1); PG8_BAR; PG8_SCHED;
            PG8_LDA(At, 0, 1); PG8_STAGE(PG8_SB(0, 0), b2, voffB); PG8_STAGE(PG8_SB(0, 1), b2 + hstep, voffB); PG8_STAGE(PG8_SA(0, 0), a2, voffA);
            PG8_WAIT_V(8); PG8_WAIT_L(0); PG8_BAR; PG8_MMA(1, 0, At, B0); PG8_MMA(1, 1, At, B1); PG8_BAR; PG8_SCHED;
            PG8_LDB(B0, 1, 0); PG8_LDB(B1, 1, 1); PG8_SCHED; PG8_LDA(At, 1, 0); PG8_STAGE(PG8_SA(0, 1), a2 + hstep, voffA);
            PG8_WAIT_V(8); PG8_WAIT_L(0); PG8_BAR; PG8_MMA(0, 0, At, B0); PG8_MMA(0, 1, At, B1); PG8_BAR; PG8_SCHED;
            PG8_LDA(At, 1, 1); PG8_STAGE(PG8_SB(1, 0), b3, voffB); PG8_STAGE(PG8_SB(1, 1), b3 + hstep, voffB); PG8_STAGE(PG8_SA(1, 0), a3, voffA);
            PG8_WAIT_V(8); PG8_WAIT_L(0); PG8_BAR; PG8_MMA(1, 0, At, B0); PG8_MMA(1, 1, At, B1); PG8_BAR; PG8_SCHED;
            } else {
            PG8_LDB(B0, 0, 0); PG8_SCHED; PG8_LDA(At, 0, 0); PG8_STAGE(PG8_SA(1, 1), a1 + hstep, voffA);
            PG8_WAIT_L(8); PG8_BAR; PG8_WAIT_L(0); PG8_MMA(0, 0, At, B0); PG8_BAR; PG8_SCHED;
            PG8_LDB(B1, 0, 1); PG8_STAGE(PG8_SB(0, 0), b2, voffB);
            PG8_BAR; PG8_WAIT_L(0); PG8_MMA(0, 1, At, B1); PG8_BAR;
            PG8_LDA(At, 0, 1); PG8_STAGE(PG8_SA(0, 0), a2, voffA);
            PG8_BAR; PG8_WAIT_L(0); PG8_MMA(1, 0, At, B0); PG8_BAR; PG8_SCHED;
            PG8_STAGE(PG8_SB(0, 1), b2 + hstep, voffB);
            PG8_WAIT_V(6); PG8_BAR; PG8_MMA(1, 1, At, B1); PG8_BAR;
            PG8_LDB(B0, 1, 0); PG8_SCHED; PG8_LDA(At, 1, 0); PG8_STAGE(PG8_SA(0, 1), a2 + hstep, voffA);
            PG8_WAIT_L(8); PG8_BAR; PG8_WAIT_L(0); PG8_MMA(0, 0, At, B0); PG8_BAR; PG8_SCHED;
            PG8_LDB(B1, 1, 1); PG8_STAGE(PG8_SB(1, 0), b3, voffB);
            PG8_BAR; PG8_WAIT_L(0); PG8_MMA(0, 1, At, B1); PG8_BAR;
            PG8_LDA(At, 1, 1); PG8_STAGE(PG8_SA(1, 0), a3, voffA);
            PG8_BAR; PG8_WAIT_L(0); PG8_MMA(1, 0, At, B0); PG8_BAR; PG8_SCHED;
            PG8_STAGE(PG8_SB(1, 1), b3 + hstep, voffB);
            PG8_WAIT_V(6); PG8_BAR; PG8_MMA(1, 1, At, B1); PG8_BAR;
            }
        }
        if constexpr (ALIGN_EPI) { if (wr == 0) PG8_BAR; }
        if constexpr (!Epi::AFTER_DRAIN) { E(acc, cur, wr, wc, fr, fq); S.done(cur); }
        if (!has_next) break;
#pragma unroll
        for (int a = 0; a < 2; ++a)
#pragma unroll
            for (int b = 0; b < 2; ++b)
#pragma unroll
                for (int m = 0; m < 4; ++m)
#pragma unroll
                    for (int n = 0; n < 2; ++n) acc[a][b][m][n] = (f32x4){0.f, 0.f, 0.f, 0.f};
        cur = nxt; cA = nA; cB = nB; ++ui;
        if constexpr (ALIGN_EPI) { if (wr == 1) PG8_BAR; }
    }
    PG8_WAIT_V(0);
    if constexpr (!ALIGN_EPI) { if (wr == 0) PG8_BAR; }
    PG8_BAR;
    if constexpr (Epi::AFTER_DRAIN) { E.fused(acc, cur, wr, wc, fr, fq, lds, wid, lane); S.done(cur); }
#undef PG8_SA
#undef PG8_SB
#undef PG8_STAGE
#undef PG8_LDA
#undef PG8_LDB
#undef PG8_MMA
#undef PG8_WAIT_V
#undef PG8_WAIT_L
#undef PG8_BAR
#undef PG8_SCHED
}
}
constexpr int D = 2048, TP = 8192, TS = 512, T = TP + TS, NCH = T / 64, NPC = TP / 64;
constexpr int RH = 8, DK = 256, DV = 512, NIN = 12288, NVD = 4096;
constexpr int FF = 4096;
constexpr float EPS = 1e-6f;
constexpr int NTHREADS = 512, NWAVES = 8;
constexpr int LDS_BYTES = 147456;

#define LAS __attribute__((address_space(3)))
typedef unsigned short bf16_t;
typedef short bf16x8 __attribute__((ext_vector_type(8)));
typedef float f32x4 __attribute__((ext_vector_type(4)));
typedef float f32x2 __attribute__((ext_vector_type(2)));
typedef unsigned u32x4 __attribute__((ext_vector_type(4)));
typedef unsigned u32x2 __attribute__((ext_vector_type(2)));

constexpr size_t MiB = 1u << 20;
constexpr size_t WS_BAR = 0;
constexpr size_t WS_RSS = 0;
constexpr size_t WS_COS = 1 * MiB, WS_SIN = 5 * MiB;
constexpr size_t WS_F = 9 * MiB;
constexpr size_t WS_X = 18 * MiB;
constexpr size_t WS_XB = 86 * MiB;
constexpr size_t WS_WIN = 120 * MiB, WS_WOUT = 216 * MiB, WS_WGLU = 248 * MiB, WS_WUP = 280 * MiB, WS_WDN = 408 * MiB;
constexpr size_t WS_Q = 472 * MiB, WS_K = 506 * MiB, WS_KT = 540 * MiB, WS_VT = 574 * MiB, WS_G = 642 * MiB;
constexpr size_t WS_ST = 710 * MiB;
constexpr size_t WS_A = 710 * MiB, WS_B = 778 * MiB, WS_HM = 846 * MiB;
constexpr size_t WS_P = WS_Q;
constexpr size_t WS_GL = WS_Q;
constexpr size_t WS_RSP = 982 * MiB;
constexpr size_t WS_END = 1004 * MiB;

constexpr size_t O_Y = 0, O_RETP = 17825792, O_RETS = 19922944, O_REP = 36700160, O_IMP = 36716544, O_RES = 36732928, O_IMS = 36864000, O_CVP = 36995072, O_CVS = 37027840, O_END = 37289984;

struct Args { const float* in[25]; float* out; unsigned char* ws; int ph_lo, ph_hi, coop, pad; };
typedef const __attribute__((address_space(4))) Args KArgs;
__device__ __forceinline__ KArgs* kargs() { KArgs* p = (KArgs*)__builtin_amdgcn_kernarg_segment_ptr(); asm volatile("" : "+s"(p)); return p; }
#define KARGS KArgs& a = *kargs()
enum { I_XP = 0, I_XS, I_SRET, I_SRE, I_SIM, I_CACHE, I_NMIX, I_NFFN, I_NFIN, I_WIN, I_GN, I_WOUT, I_ARE, I_AIM, I_LDT, I_BRE, I_BIM, I_CRE, I_CIM, I_SD, I_WGLU, I_WUP, I_CW, I_CB, I_WDN };

__device__ __forceinline__ unsigned f2bf(float f) { unsigned u = __builtin_bit_cast(unsigned, f); return (u + 0x7fffu + ((u >> 16) & 1u)) >> 16; }
typedef __bf16 bf16x2_t __attribute__((ext_vector_type(2)));
__device__ __forceinline__ unsigned pk2(float lo, float hi) { const f32x2 v = {lo, hi}; const bf16x2_t b = __builtin_convertvector(v, bf16x2_t); return __builtin_bit_cast(unsigned, b); }
__device__ __forceinline__ float bflo(unsigned w) { return __builtin_bit_cast(float, w << 16); }
__device__ __forceinline__ float bfhi(unsigned w) { return __builtin_bit_cast(float, w & 0xffff0000u); }
__device__ __forceinline__ void store8bf(bf16_t* p, f32x4 a, f32x4 b) { u32x4 w; w.x = pk2(a[0], a[1]); w.y = pk2(a[2], a[3]); w.z = pk2(b[0], b[1]); w.w = pk2(b[2], b[3]); *(u32x4*)p = w; }
__device__ __forceinline__ float log2gamma(int h) { return log1pf(-exp2f(-5.0f - (float)h)) * 1.4426950408889634f; }
__device__ __forceinline__ float silu_f(float v) { return v / (1.0f + __expf(-v)); }
__device__ __forceinline__ float sigmoid_f(float v) { return 1.0f / (1.0f + __expf(-v)); }
__device__ __forceinline__ float gelu_tanh(float v) { const float z = 0.7978845608028654f * (v + 0.044715f * v * v * v); return v * (1.0f - 1.0f / (1.0f + __expf(2.0f * z))); }
__device__ __forceinline__ float wave_sum(float v) {
#pragma unroll
    for (int o = 1; o < 64; o <<= 1) v += __shfl_xor(v, o);
    return v;
}

__device__ __forceinline__ float row_rstd(const float* rsp, int t, int n4, int fq) {
    const f32x4* p = (const f32x4*)(rsp + (size_t)t * 64) + fq * n4; float s = 0.f;
    for (int i = 0; i < n4; ++i) { const f32x4 v = p[i]; s += (v[0] + v[1]) + (v[2] + v[3]); }
    s += __shfl_xor(s, 16); s += __shfl_xor(s, 32);
    return rsqrtf(s * (1.0f / D) + EPS);
}
struct EpiRetIn {
    static constexpr bool PERM = true, AFTER_DRAIN = false;
    unsigned char* ws; int li;
    __device__ __forceinline__ void operator()(const f32x4 (&acc)[2][2][4][2], const pg8::Unit& u, int wr, int wc, int fr, int fq) const {
        const float* rsp = (const float*)(ws + WS_RSP) + (size_t)(2 * li) * T * 64; const float* cosT = (const float*)(ws + WS_COS); const float* sinT = (const float*)(ws + WS_SIN);
        bf16_t* Q = (bf16_t*)(ws + WS_Q); bf16_t* K = (bf16_t*)(ws + WS_K); bf16_t* KT = (bf16_t*)(ws + WS_KT); bf16_t* VT = (bf16_t*)(ws + WS_VT); bf16_t* G = (bf16_t*)(ws + WS_G);
        const int pn = u.pn, rowb = u.pm * 256 + wr * 64 + fr, cl = wc * 32 + 8 * fq;
        if (pn < 16) {
            const bool isk = pn >= 8; const int h = pn & 7; const float l2g = log2gamma(h);
            bf16_t* dst = (isk ? K : Q) + h * 256 + cl;
#pragma unroll
            for (int ai = 0; ai < 2; ++ai)
#pragma unroll
                for (int m = 0; m < 4; ++m) {
                    const int t = rowb + ai * 128 + m * 16;
                    float rs = row_rstd(rsp, t, 2, fq); if (isk) rs *= 0.0625f;
                    const int pos = t < TP ? t : 1024 + (t & 63);
                    const f32x4 c0 = *(const f32x4*)(cosT + pos * 128 + cl), c1 = *(const f32x4*)(cosT + pos * 128 + cl + 4);
                    const f32x4 s0 = *(const f32x4*)(sinT + pos * 128 + cl), s1 = *(const f32x4*)(sinT + pos * 128 + cl + 4);
                    const f32x4 x1a = acc[ai][0][m][0] * rs, x1b = acc[ai][0][m][1] * rs, x2a = acc[ai][1][m][0] * rs, x2b = acc[ai][1][m][1] * rs;
                    const f32x4 o1a = x1a * c0 - x2a * s0, o1b = x1b * c1 - x2b * s1, o2a = x1a * s0 + x2a * c0, o2b = x1b * s1 + x2b * c1;
                    store8bf(dst + (size_t)t * 2048, o1a, o1b); store8bf(dst + (size_t)t * 2048 + 128, o2a, o2b);
                    if (isk) {
                        const int chunk = t >> 6, l = t & 63; const float dec = exp2f((float)(63 - l) * l2g);
                        bf16_t* kt = KT + ((size_t)(chunk * 8 + h) * 256 + cl) * 64 + l;
#pragma unroll
                        for (int jj = 0; jj < 4; jj += 2) {
                            unsigned w = pk2(o1a[jj] * dec, o1a[jj + 1] * dec); kt[jj * 64] = (bf16_t)w; kt[(jj + 1) * 64] = (bf16_t)(w >> 16);
                            w = pk2(o1b[jj] * dec, o1b[jj + 1] * dec); kt[(4 + jj) * 64] = (bf16_t)w; kt[(5 + jj) * 64] = (bf16_t)(w >> 16);
                            w = pk2(o2a[jj] * dec, o2a[jj + 1] * dec); kt[(128 + jj) * 64] = (bf16_t)w; kt[(129 + jj) * 64] = (bf16_t)(w >> 16);
                            w = pk2(o2b[jj] * dec, o2b[jj + 1] * dec); kt[(132 + jj) * 64] = (bf16_t)w; kt[(133 + jj) * 64] = (bf16_t)(w >> 16); }
                    }
                }
        } else if (pn < 32) {
            const int pv = pn - 16, h = pv >> 1, eb = (pv & 1) * 256 + cl;
#pragma unroll
            for (int ai = 0; ai < 2; ++ai)
#pragma unroll
                for (int m = 0; m < 4; ++m) {
                    const int t = rowb + ai * 128 + m * 16; const float rs = row_rstd(rsp, t, 2, fq);
                    const int chunk = t >> 6, l = t & 63;
                    bf16_t* vt = VT + ((size_t)(chunk * 8 + h) * 512 + eb) * 64 + l;
#pragma unroll
                    for (int bj = 0; bj < 2; ++bj)
#pragma unroll
                        for (int n = 0; n < 2; ++n)
#pragma unroll
                            for (int jj = 0; jj < 4; jj += 2) { const unsigned w = pk2(acc[ai][bj][m][n][jj] * rs, acc[ai][bj][m][n][jj + 1] * rs);
                                vt[(bj * 128 + 4 * n + jj) * 64] = (bf16_t)w; vt[(bj * 128 + 4 * n + jj + 1) * 64] = (bf16_t)(w >> 16); }
                }
        } else {
            const int gcol = (pn - 32) * 256 + cl;
#pragma unroll
            for (int ai = 0; ai < 2; ++ai)
#pragma unroll
                for (int m = 0; m < 4; ++m) {
                    const int t = rowb + ai * 128 + m * 16; const float rs = row_rstd(rsp, t, 2, fq);
#pragma unroll
                    for (int bj = 0; bj < 2; ++bj) { f32x4 v0 = acc[ai][bj][m][0] * rs, v1 = acc[ai][bj][m][1] * rs;
#pragma unroll
                        for (int jj = 0; jj < 4; ++jj) { v0[jj] = silu_f(v0[jj]); v1[jj] = silu_f(v1[jj]); }
                        store8bf(G + (size_t)t * NVD + gcol + bj * 128, v0, v1); }
                }
        }
    }
};

template <bool GLU> struct EpiRes {
    static constexpr bool PERM = true, AFTER_DRAIN = false;
    unsigned char* ws; int nidx; int dry;
    __device__ __forceinline__ void operator()(const f32x4 (&acc)[2][2][4][2], const pg8::Unit& u, int wr, int wc, int fr, int fq) const {
        float* X = (float*)(ws + WS_X); bf16_t* XB = (bf16_t*)(ws + WS_XB); float* rsp_next = (float*)(ws + WS_RSP) + (size_t)nidx * T * 64;
        if (!GLU && u.nt == 4) {
            float* P = (float*)(ws + WS_P) + (size_t)(u.koff >> 9) * TS * D;
            const int rowp = (u.pm - TP / 256) * 256 + wr * 64 + fr, colp = u.pn * 256 + wc * 32 + 8 * fq;
#pragma unroll
            for (int ai = 0; ai < 2; ++ai)
#pragma unroll
                for (int m = 0; m < 4; ++m) { int rr_ = rowp + ai * 128 + m * 16; asm volatile("" : "+v"(rr_)); float* pr = P + (size_t)rr_ * D + colp;
#pragma unroll
                    for (int bj = 0; bj < 2; ++bj) { *(f32x4*)(pr + bj * 128) = acc[ai][bj][m][0]; *(f32x4*)(pr + bj * 128 + 4) = acc[ai][bj][m][1]; } }
            return;
        }
        const int rowb = u.pm * 256 + wr * 64 + fr, colb = u.pn * (GLU ? 128 : 256) + wc * 32 + 8 * fq;
#pragma unroll
        for (int ai = 0; ai < 2; ++ai)
#pragma unroll
            for (int m = 0; m < 4; ++m) {
                const int t = rowb + ai * 128 + m * 16; float ss = 0.f;
                float* xr = X + (size_t)t * D + colb; bf16_t* xbr = XB + (size_t)t * D + colb;
                if (GLU) {
                    f32x4 y0, y1;
#pragma unroll
                    for (int jj = 0; jj < 4; ++jj) { y0[jj] = acc[ai][0][m][0][jj] * sigmoid_f(acc[ai][1][m][0][jj]); y1[jj] = acc[ai][0][m][1][jj] * sigmoid_f(acc[ai][1][m][1][jj]); }
                    const f32x4 x0 = *(const f32x4*)xr + y0, x1 = *(const f32x4*)(xr + 4) + y1;
                    if (!dry) { *(f32x4*)xr = x0; *(f32x4*)(xr + 4) = x1; store8bf(xbr, x0, x1); }
                    ss += (x0[0] * x0[0] + x0[1] * x0[1]) + (x0[2] * x0[2] + x0[3] * x0[3]) + (x1[0] * x1[0] + x1[1] * x1[1]) + (x1[2] * x1[2] + x1[3] * x1[3]);
                } else {
#pragma unroll
                    for (int bj = 0; bj < 2; ++bj) {
                        const f32x4 x0 = *(const f32x4*)(xr + bj * 128) + acc[ai][bj][m][0], x1 = *(const f32x4*)(xr + bj * 128 + 4) + acc[ai][bj][m][1];
                        if (!dry) { *(f32x4*)(xr + bj * 128) = x0; *(f32x4*)(xr + bj * 128 + 4) = x1; store8bf(xbr + bj * 128, x0, x1); }
                        ss += (x0[0] * x0[0] + x0[1] * x0[1]) + (x0[2] * x0[2] + x0[3] * x0[3]) + (x1[0] * x1[0] + x1[1] * x1[1]) + (x1[2] * x1[2] + x1[3] * x1[3]);
                    }
                }
                ss += __shfl_xor(ss, 16); ss += __shfl_xor(ss, 32);
                if (fq == 0 && !dry) rsp_next[(size_t)t * 64 + u.pn * 4 + wc] = ss;
            }
    }
};

struct EpiUp {
    static constexpr bool PERM = true, AFTER_DRAIN = false;
    unsigned char* ws; float* out; int li;
    __device__ __forceinline__ void operator()(const f32x4 (&acc)[2][2][4][2], const pg8::Unit& u, int wr, int wc, int fr, int fq) const {
        const float* rsp = (const float*)(ws + WS_RSP) + (size_t)(2 * li + 1) * T * 64; const int n4 = (li & 1) ? 4 : 2; bf16_t* A_ = (bf16_t*)(ws + WS_A); bf16_t* B_ = (bf16_t*)(ws + WS_B);
        float* cvp = out + O_CVP + (size_t)li * 2 * FF; float* cvs = out + O_CVS + (size_t)li * 16 * FF;
        const int pn = u.pn, rowb = u.pm * 256 + wr * 64 + fr, colb = (pn & 15) * 256 + wc * 32 + 8 * fq; const bool isb = pn >= 16;
        bf16_t* dst = (isb ? B_ : A_) + colb;
#pragma unroll
        for (int ai = 0; ai < 2; ++ai)
#pragma unroll
            for (int m = 0; m < 4; ++m) {
                const int t = rowb + ai * 128 + m * 16; const float rs = row_rstd(rsp, t, n4, fq);
                float* cp = nullptr;
                if (!isb) { if (t >= TP - 2 && t < TP) cp = cvp + (size_t)(t - (TP - 2)) * FF + colb; else if (t >= TP && (t & 63) >= 62) cp = cvs + (size_t)(((t - TP) >> 6) * 2 + (t & 63) - 62) * FF + colb; }
#pragma unroll
                for (int bj = 0; bj < 2; ++bj) { const f32x4 v0 = acc[ai][bj][m][0] * rs, v1 = acc[ai][bj][m][1] * rs;
                    store8bf(dst + (size_t)t * FF + bj * 128, v0, v1);
                    if (cp) { *(f32x4*)(cp + bj * 128) = v0; *(f32x4*)(cp + bj * 128 + 4) = v1; } }
            }
    }
};
#define XB_TMO      128
#define XB_XCNT(j)  (256  + 64 * (j))
#define XB_XSUB(j)  (1280 + 64 * (j))
#define XB_XGEN(j)  (2304 + 64 * (j))
#define XB_TOP      3328
#define XB_TOPGEN   3392
#define XCD_BAR_WORDS 3456
#define XB_SPIN_CAP (1u << 18)

__device__ __forceinline__ unsigned xb_ld(unsigned* p)              { return __hip_atomic_load(p, __ATOMIC_RELAXED, __HIP_MEMORY_SCOPE_AGENT); }
__device__ __forceinline__ unsigned xb_add(unsigned* p, unsigned v) { return __hip_atomic_fetch_add(p, v, __ATOMIC_RELAXED, __HIP_MEMORY_SCOPE_AGENT); }
__device__ __forceinline__ unsigned xb_xcc_id() { return (unsigned)__builtin_amdgcn_s_getreg((3 << 11) | 20) & 0xFu; }
#define XB_SPIN(cond, bar) do { unsigned _sp = 0; while (cond) { __builtin_amdgcn_s_sleep(1); \
    if ((++_sp & 255u) == 0u) { if (xb_ld(&(bar)[XB_TMO])) break; if (_sp > XB_SPIN_CAP) { atomicAdd(&(bar)[XB_TMO], 1u); break; } } } } while (0)

struct XcdBarrier {
    unsigned* bar; unsigned x;
    volatile LAS unsigned* st;
};

__device__ __forceinline__ XcdBarrier xcd_barrier_post(unsigned* bar, volatile LAS unsigned* st) {
    XcdBarrier b; b.bar = bar; b.x = xb_xcc_id(); b.st = st;
    if (threadIdx.x == 0) (void)xb_add(&bar[XB_XCNT(b.x)], 1u);
    return b;
}
__device__ __forceinline__ void xcd_barrier_complete(unsigned* bar, unsigned x, unsigned& nloc, unsigned& nx) {
    const unsigned G = gridDim.x * gridDim.y * gridDim.z;
    unsigned sum, cnt, mine, sp = 0u;
    for (;;) {
        sum = 0u; cnt = 0u; mine = 0u;
#pragma unroll
        for (unsigned j = 0; j < 16; ++j) { const unsigned c = xb_ld(&bar[XB_XCNT(j)]); sum += c; cnt += (c > 0u) ? 1u : 0u; mine = (j == x) ? c : mine; }
        if (sum == G) break;
        __builtin_amdgcn_s_sleep(1);
        if ((++sp & 255u) == 0u) { if (xb_ld(&bar[XB_TMO])) break; if (sp > XB_SPIN_CAP) { atomicAdd(&bar[XB_TMO], 1u); break; } }
    }
    nloc = mine > 0u ? mine : 1u; nx = cnt > 0u ? cnt : 1u;
}

__device__ __forceinline__ void xcd_barrier(const XcdBarrier& b) {
    asm volatile("s_waitcnt vmcnt(0)" ::: "memory");
    __syncthreads();
    if (threadIdx.x == 0) {
        unsigned* bar = b.bar;
        __builtin_amdgcn_s_waitcnt(0);
        unsigned nloc = b.st[0], nx = b.st[1];
        if (nloc == 0u) { xcd_barrier_complete(bar, b.x, nloc, nx); b.st[0] = nloc; b.st[1] = nx; }
        const unsigned old = xb_add(&bar[XB_XSUB(b.x)], 1u);
        const unsigned gen = old / nloc;
        if (old + 1u == (gen + 1u) * nloc) {
            __builtin_amdgcn_fence(__ATOMIC_RELEASE, "agent");
            asm volatile("s_waitcnt vmcnt(0)" ::: "memory");
            const unsigned og = xb_add(&bar[XB_TOP], 1u);
            const unsigned tg = og / nx;
            if (og + 1u == (tg + 1u) * nx) xb_add(&bar[XB_TOPGEN], 1u);
            else XB_SPIN(xb_ld(&bar[XB_TOPGEN]) == tg, bar);
            __builtin_amdgcn_fence(__ATOMIC_ACQUIRE, "agent");
            xb_add(&bar[XB_XGEN(b.x)], 1u);
            asm volatile("s_waitcnt vmcnt(0)" ::: "memory");
        } else {
            XB_SPIN(xb_ld(&bar[XB_XGEN(b.x)]) == gen, bar);
            __builtin_amdgcn_fence(__ATOMIC_ACQUIRE, "agent");
            asm volatile("s_waitcnt vmcnt(0)" ::: "memory");
        }
    }
    __syncthreads();
}
struct WTile { const float* W; bf16_t* Wt; const float* ks; int K, N, k0, n0, mode; };
__device__ __forceinline__ WTile decode_tile(int it) { KARGS;
    WTile w; int r, nt;
    if (it < 3072) { const int j = it / 1536; r = it % 1536; nt = 48; w.K = 2048; w.N = NIN; w.W = a.in[I_WIN] + (size_t)j * 2048 * NIN; w.Wt = (bf16_t*)(a.ws + WS_WIN) + (size_t)j * NIN * 2048; w.ks = a.in[I_NMIX] + (2 * j) * D; w.mode = 0; }
    else if (it < 4096) { it -= 3072; const int j = it / 512; r = it % 512; nt = 8; w.K = 4096; w.N = 2048; w.W = a.in[I_WOUT] + (size_t)j * 4096 * 2048; w.Wt = (bf16_t*)(a.ws + WS_WOUT) + (size_t)j * 2048 * 4096; w.ks = nullptr; w.mode = 0; }
    else if (it < 5120) { it -= 4096; const int j = it / 512; r = it % 512; nt = 16; w.K = 2048; w.N = 4096; w.W = a.in[I_WGLU] + (size_t)j * 2048 * 4096; w.Wt = (bf16_t*)(a.ws + WS_WGLU) + (size_t)j * 4096 * 2048; w.ks = nullptr; w.mode = 1; }
    else if (it < 9216) { it -= 5120; const int i = it / 1024; r = it % 1024; nt = 32; w.K = 2048; w.N = 8192; w.W = a.in[I_WUP] + (size_t)i * 2048 * 8192; w.Wt = (bf16_t*)(a.ws + WS_WUP) + (size_t)i * 8192 * 2048; w.ks = a.in[I_NFFN] + i * D; w.mode = 0; }
    else { it -= 9216; const int i = it / 512; r = it % 512; nt = 8; w.K = 4096; w.N = 2048; w.W = a.in[I_WDN] + (size_t)i * 4096 * 2048; w.Wt = (bf16_t*)(a.ws + WS_WDN) + (size_t)i * 2048 * 4096; w.ks = nullptr; w.mode = 0; }
    w.k0 = (r / nt) * 64; w.n0 = (r % nt) * 256; return w;
}
constexpr int N_WTILES = 11264, TPITCH = 520;
__device__ __forceinline__ void tile_load(const WTile& w, int lane, int wave, f32x4 (&v)[8]) {
#pragma unroll
    for (int i = 0; i < 8; ++i) v[i] = __builtin_nontemporal_load((const f32x4*)(w.W + (size_t)(w.k0 + 8 * wave + i) * w.N + w.n0 + 4 * lane));
}
__device__ __forceinline__ void prologue(LAS unsigned char* lds, int tid, int lane, int wave) {
    KARGS; const int G = gridDim.x;
    {
        f32x4 va[8], vb[8]; WTile wa, wb; int it = blockIdx.x;
        if (it < N_WTILES) { wa = decode_tile(it); tile_load(wa, lane, wave, va); }
        if (it + G < N_WTILES) { wb = decode_tile(it + G); tile_load(wb, lane, wave, vb); }
#define WT_PROCESS(W, V, NEXT) do { \
            _Pragma("unroll") for (int i = 0; i < 8; ++i) { const int kr = 8 * wave + i; const float sc_ = W.ks ? W.ks[W.k0 + kr] : 1.0f; \
                u32x2 p; p.x = pk2(V[i][0] * sc_, V[i][1] * sc_); p.y = pk2(V[i][2] * sc_, V[i][3] * sc_); *(LAS u32x2*)(lds + kr * TPITCH + lane * 8) = p; } \
            __syncthreads(); \
            const WTile wc_ = W; const int itn_ = (NEXT); \
            if (itn_ < N_WTILES) { W = decode_tile(itn_); tile_load(W, lane, wave, V); } \
            _Pragma("unroll") for (int q = 0; q < 4; ++q) { \
                const int n = q * 64 + (tid >> 3), kc = tid & 7; unsigned short e[8]; \
                _Pragma("unroll") for (int jj = 0; jj < 8; ++jj) e[jj] = *(const LAS unsigned short*)(lds + (kc * 8 + jj) * TPITCH + n * 2); \
                u32x4 o; o.x = e[0] | ((unsigned)e[1] << 16); o.y = e[2] | ((unsigned)e[3] << 16); o.z = e[4] | ((unsigned)e[5] << 16); o.w = e[6] | ((unsigned)e[7] << 16); \
                const int s_ = wc_.n0 + n; int dr = s_; \
                if (wc_.mode == 1) dr = (s_ < 2048) ? (256 * (s_ >> 7) + (s_ & 127)) : (256 * ((s_ - 2048) >> 7) + 128 + (s_ & 127)); \
                *(u32x4*)(wc_.Wt + (size_t)dr * wc_.K + wc_.k0 + kc * 8) = o; } \
            __syncthreads(); } while (0)
        for (; it < N_WTILES; it += 2 * G) {
            WT_PROCESS(wa, va, it + 2 * G);
            if (it + G < N_WTILES) WT_PROCESS(wb, vb, it + 3 * G);
        }
#undef WT_PROCESS
    }
    const int gw = blockIdx.x * NWAVES + wave, NGW = G * NWAVES;
    {
        float* X = (float*)(a.ws + WS_X); bf16_t* XB = (bf16_t*)(a.ws + WS_XB); float* rsp = (float*)(a.ws + WS_RSP);
        for (int t = gw; t < T; t += NGW) {
            const float* src = t < TP ? a.in[I_XP] + (size_t)t * D : a.in[I_XS] + (size_t)(t - TP) * D; float ss = 0.f;
#pragma unroll
            for (int jj = 0; jj < 8; ++jj) { const int c = 4 * (lane + 64 * jj); const f32x4 x = *(const f32x4*)(src + c);
                *(f32x4*)(X + (size_t)t * D + c) = x; u32x2 p; p.x = pk2(x[0], x[1]); p.y = pk2(x[2], x[3]); *(u32x2*)(XB + (size_t)t * D + c) = p;
                ss += (x[0] * x[0] + x[1] * x[1]) + (x[2] * x[2] + x[3] * x[3]); }
            ss = wave_sum(ss);
            if (lane < 32) rsp[(size_t)t * 64 + lane] = lane == 0 ? ss : 0.f;
        }
    }
    {
        float* cosT = (float*)(a.ws + WS_COS); float* sinT = (float*)(a.ws + WS_SIN);
        for (int e = blockIdx.x * NTHREADS + tid; e < 8192 * 128; e += G * NTHREADS) {
            const int pos = e >> 7, d = e & 127; const float inv = exp2f(-(float)d * (13.287712379549449f / 128.0f)); const float ang = (float)pos * inv;
            float s, c; sincosf(ang, &s, &c); cosT[e] = c; sinT[e] = s;
        }
    }
}

constexpr int RS_D = 8, RS_PITCH = 144, RS_TILE = 64 * RS_PITCH, RS_STAGE = 2 * RS_TILE;
__device__ __forceinline__ void ret_scan_phase(int j, LAS unsigned char* lds, int tid, int lane, int wave) { KARGS;
    const int fr = lane & 15, fq = lane >> 4;
    const bf16_t* KT = (const bf16_t*)(a.ws + WS_KT); const bf16_t* VT = (const bf16_t*)(a.ws + WS_VT); bf16_t* ST = (bf16_t*)(a.ws + WS_ST);
    constexpr size_t KCS = (size_t)8 * 256 * 64, VCS = (size_t)8 * 512 * 64;
    for (int item = blockIdx.x; item < 256; item += gridDim.x) {
        const int h = item & 7, dq = (item >> 3) & 3, eo = item >> 5;
        const float g64 = exp2f(64.0f * log2gamma(h));
        const int lrow = tid >> 3, lpc = tid & 7;
        const bf16_t* kg = KT + ((size_t)h * 256 + 64 * dq + lrow) * 64 + lpc * 8;
        const bf16_t* vg = VT + ((size_t)h * 512 + 64 * eo + lrow) * 64 + lpc * 8;
        const int lw = lrow * RS_PITCH + lpc * 16;
        const int dtw = wave & 3, ep = wave >> 2;
        const int ka_off = (16 * dtw + fr) * RS_PITCH + 16 * fq, vb_off = RS_TILE + (32 * ep + fr) * RS_PITCH + 16 * fq;
        const int d0 = 64 * dq + 16 * dtw + 4 * fq, e0 = 64 * eo + 32 * ep + fr;
        float sst[8][8];
#pragma unroll
        for (int b = 0; b < 8; ++b) { const float* sp = a.in[I_SRET] + ((size_t)((j * 8 + b) * 8 + h) * 256 + d0) * 512 + e0;
#pragma unroll
            for (int r = 0; r < 4; ++r) { sst[b][r] = sp[(size_t)r * 512]; sst[b][4 + r] = sp[(size_t)r * 512 + 16]; } }
        u32x4 kr[RS_D], vr[RS_D];
#pragma unroll
        for (int s = 0; s < RS_D; ++s) { kr[s] = *(const u32x4*)(kg + s * KCS); vr[s] = *(const u32x4*)(vg + s * VCS); }
        *(LAS u32x4*)(lds + lw) = kr[0]; *(LAS u32x4*)(lds + RS_TILE + lw) = vr[0];
        kr[0] = *(const u32x4*)(kg + RS_D * KCS); vr[0] = *(const u32x4*)(vg + RS_D * VCS);
        __syncthreads();
        f32x4 acc0 = {0.f, 0.f, 0.f, 0.f}, acc1 = {0.f, 0.f, 0.f, 0.f};
#pragma unroll 1
        for (int c0 = 0; c0 < NCH; c0 += RS_D) {
            const bool samp = c0 >= NPC;
#pragma unroll
            for (int s = 0; s < RS_D; ++s) {
                const int c = c0 + s;
                { constexpr int dummy = 0; (void)dummy; const int sl = (s + 1) % RS_D; LAS unsigned char* st = lds + ((c + 1) & 1) * RS_STAGE;
                  *(LAS u32x4*)(st + lw) = kr[sl]; *(LAS u32x4*)(st + RS_TILE + lw) = vr[sl];
                  int cn = c + 1 + RS_D; cn = cn < NCH ? cn : NCH - 1;
                  kr[sl] = *(const u32x4*)(kg + cn * KCS); vr[sl] = *(const u32x4*)(vg + cn * VCS); }
                if (samp) {
#pragma unroll
                    for (int r = 0; r < 4; ++r) { acc0[r] = sst[s][r]; acc1[r] = sst[s][4 + r]; }
                }
                if (samp ? (s > 0) : (s & 1)) { const int sbp = samp ? ((s - 1) & 1) : (((s - 1) >> 1) & 1);
                  const u32x4 vv = *(const LAS u32x4*)(lds + 2 * RS_STAGE + sbp * RS_TILE + (tid >> 3) * RS_PITCH + (tid & 7) * 16);
                  *(u32x4*)(ST + ((size_t)((c - 1) * 8 + h) * 512 + 64 * eo + (tid >> 3)) * 256 + 64 * dq + (tid & 7) * 8) = vv; }
                if (samp || !(s & 1)) { const int sb = samp ? (s & 1) : ((s >> 1) & 1);
                  LAS unsigned char* sp = lds + 2 * RS_STAGE + sb * RS_TILE + (32 * ep + fr) * RS_PITCH + (16 * dtw + 4 * fq) * 2;
                  u32x2 p; p.x = pk2(acc0[0], acc0[1]); p.y = pk2(acc0[2], acc0[3]); *(LAS u32x2*)sp = p;
                  p.x = pk2(acc1[0], acc1[1]); p.y = pk2(acc1[2], acc1[3]); *(LAS u32x2*)(sp + 16 * RS_PITCH) = p; }
                acc0 *= g64; acc1 *= g64;
                { const LAS unsigned char* st = lds + (c & 1) * RS_STAGE;
#pragma unroll
                  for (int ks = 0; ks < 2; ++ks) { const bf16x8 kf = *(const LAS bf16x8*)(st + ka_off + 64 * ks), v0 = *(const LAS bf16x8*)(st + vb_off + 64 * ks), v1 = *(const LAS bf16x8*)(st + vb_off + 16 * RS_PITCH + 64 * ks);
                      acc0 = __builtin_amdgcn_mfma_f32_16x16x32_bf16(kf, v0, acc0, 0, 0, 0); acc1 = __builtin_amdgcn_mfma_f32_16x16x32_bf16(kf, v1, acc1, 0, 0, 0); } }
                if (samp || c == NPC - 1) {
                    float* op = samp ? a.out + O_RETS + ((size_t)((j * 8 + s) * 8 + h) * 256 + d0) * 512 + e0 : a.out + O_RETP + ((size_t)(j * 8 + h) * 256 + d0) * 512 + e0;
#pragma unroll
                    for (int r = 0; r < 4; ++r) { op[(size_t)r * 512] = acc0[r]; op[(size_t)r * 512 + 16] = acc1[r]; }
                }
                __syncthreads();
            }
        }
        { const u32x4 vv = *(const LAS u32x4*)(lds + 2 * RS_STAGE + 1 * RS_TILE + (tid >> 3) * RS_PITCH + (tid & 7) * 16);
          *(u32x4*)(ST + ((size_t)((NCH - 1) * 8 + h) * 512 + 64 * eo + (tid >> 3)) * 256 + 64 * dq + (tid & 7) * 8) = vv; }
        __syncthreads();
    }
}

constexpr int QPITCH = 528, PPITCH = 144, R3_P = 33792, R3_P2 = 43008, R3_RED = 52224;
__device__ __forceinline__ void ret_out_phase(int j, LAS unsigned char* lds, int tid, int lane, int wave, int dry) { KARGS;
    const int fr = lane & 15, fq = lane >> 4;
    const bf16_t* Q = (const bf16_t*)(a.ws + WS_Q); const bf16_t* K = (const bf16_t*)(a.ws + WS_K); const bf16_t* VT = (const bf16_t*)(a.ws + WS_VT);
    const bf16_t* ST = (const bf16_t*)(a.ws + WS_ST); bf16_t* GO = (bf16_t*)(a.ws + WS_G); const float* gn = a.in[I_GN] + (size_t)j * NVD;
    LAS unsigned char* Ql = lds; LAS unsigned char* Pl = lds + R3_P; LAS unsigned char* Pl2 = lds + R3_P2; LAS float* red = (LAS float*)(lds + R3_RED);
    u32x4 qn[4];
    if ((int)blockIdx.x < NCH * RH) { const int c_ = blockIdx.x >> 3, h_ = blockIdx.x & 7;
#pragma unroll
        for (int i = 0; i < 4; ++i) { const int idx = tid + NTHREADS * i, row = idx >> 5, ch = idx & 31; qn[i] = *(const u32x4*)(Q + (size_t)(c_ * 64 + row) * 2048 + h_ * 256 + ch * 8); } }
    for (int unit = blockIdx.x; unit < NCH * RH; unit += gridDim.x) {
        const int c = unit >> 3, h = unit & 7, t0 = c * 64; const float l2g = log2gamma(h);
        const bool odd = (c < NPC) && (c & 1); const int cs = odd ? c - 1 : c;
#pragma unroll
        for (int i = 0; i < 4; ++i) { const int idx = tid + NTHREADS * i, row = idx >> 5, ch = idx & 31; *(LAS u32x4*)(Ql + row * QPITCH + ch * 16) = qn[i]; }
        const bf16_t* kp = K + (size_t)(t0 + 16 * (wave & 3) + fr) * 2048 + h * 256 + 8 * fq;
        bf16x8 kfa[8];
#pragma unroll
        for (int ks = 0; ks < 8; ++ks) kfa[ks] = *(const bf16x8*)(kp + 32 * ks);
        __syncthreads();
        {
            const int mt = wave & 3, lt0 = (wave >> 2) * 2;
            f32x4 sc[2] = {{0.f, 0.f, 0.f, 0.f}, {0.f, 0.f, 0.f, 0.f}};
#pragma unroll
            for (int ks = 0; ks < 8; ++ks) { const bf16x8 kf = kfa[ks];
#pragma unroll
                for (int i = 0; i < 2; ++i) { const bf16x8 qf = *(const LAS bf16x8*)(Ql + (16 * (lt0 + i) + fr) * QPITCH + (32 * ks + 8 * fq) * 2); sc[i] = __builtin_amdgcn_mfma_f32_16x16x32_bf16(kf, qf, sc[i], 0, 0, 0); } }
#pragma unroll
            for (int i = 0; i < 2; ++i) { const int l = 16 * (lt0 + i) + fr, m0 = 16 * mt + 4 * fq; float p[4];
#pragma unroll
                for (int r = 0; r < 4; ++r) { const int dist = l - (m0 + r); p[r] = sc[i][r] * exp2f((float)(dist < 0 ? -dist : dist) * l2g); }
                u32x2 w; w.x = pk2(p[0], p[1]); w.y = pk2(p[2], p[3]); *(LAS u32x2*)(Pl + l * PPITCH + m0 * 2) = w; }
            if (odd) {
                f32x4 s2[2] = {{0.f, 0.f, 0.f, 0.f}, {0.f, 0.f, 0.f, 0.f}};
                const bf16_t* kp2 = kp - (size_t)64 * 2048;
#pragma unroll
                for (int ks = 0; ks < 8; ++ks) { const bf16x8 kf = *(const bf16x8*)(kp2 + 32 * ks);
#pragma unroll
                    for (int i = 0; i < 2; ++i) { const bf16x8 qf = *(const LAS bf16x8*)(Ql + (16 * (lt0 + i) + fr) * QPITCH + (32 * ks + 8 * fq) * 2); s2[i] = __builtin_amdgcn_mfma_f32_16x16x32_bf16(kf, qf, s2[i], 0, 0, 0); } }
#pragma unroll
                for (int i = 0; i < 2; ++i) { const int l = 16 * (lt0 + i) + fr, m0 = 16 * mt + 4 * fq; float p[4];
#pragma unroll
                    for (int r = 0; r < 4; ++r) p[r] = s2[i][r] * exp2f((float)(64 + l - (m0 + r)) * l2g);
                    u32x2 w; w.x = pk2(p[0], p[1]); w.y = pk2(p[2], p[3]); *(LAS u32x2*)(Pl2 + l * PPITCH + m0 * 2) = w; }
            }
        }
        const bf16_t* sp = ST + ((size_t)(cs * 8 + h) * 512 + 64 * wave + fr) * 256 + 8 * fq;
        bf16x8 af[2][4];
#pragma unroll
        for (int et = 0; et < 4; ++et) af[0][et] = *(const bf16x8*)(sp + (size_t)et * 16 * 256);
        __syncthreads();
        f32x4 acc[4][4];
#pragma unroll
        for (int et = 0; et < 4; ++et)
#pragma unroll
            for (int lt = 0; lt < 4; ++lt) acc[et][lt] = (f32x4){0.f, 0.f, 0.f, 0.f};
        {
#pragma unroll
            for (int ks = 0; ks < 8; ++ks) {
                if (ks < 7) {
#pragma unroll
                    for (int et = 0; et < 4; ++et) af[(ks + 1) & 1][et] = *(const bf16x8*)(sp + (size_t)et * 16 * 256 + 32 * (ks + 1));
                }
                bf16x8 qf[4];
#pragma unroll
                for (int lt = 0; lt < 4; ++lt) qf[lt] = *(const LAS bf16x8*)(Ql + (16 * lt + fr) * QPITCH + (32 * ks + 8 * fq) * 2);
#pragma unroll
                for (int et = 0; et < 4; ++et)
#pragma unroll
                    for (int lt = 0; lt < 4; ++lt) acc[et][lt] = __builtin_amdgcn_mfma_f32_16x16x32_bf16(af[ks & 1][et], qf[lt], acc[et][lt], 0, 0, 0);
            }
        }
#pragma unroll
        for (int lt = 0; lt < 4; ++lt) { const float cr = exp2f((float)(16 * lt + fr + 1 + (odd ? 64 : 0)) * l2g);
#pragma unroll
            for (int et = 0; et < 4; ++et) acc[et][lt] *= cr; }
        {
            const bf16_t* vp = VT + ((size_t)(c * 8 + h) * 512 + 64 * wave + fr) * 64 + 8 * fq;
#pragma unroll
            for (int ks = 0; ks < 2; ++ks) {
                bf16x8 vf[4], pf[4];
#pragma unroll
                for (int et = 0; et < 4; ++et) vf[et] = *(const bf16x8*)(vp + (size_t)et * 16 * 64 + 32 * ks);
#pragma unroll
                for (int lt = 0; lt < 4; ++lt) pf[lt] = *(const LAS bf16x8*)(Pl + (16 * lt + fr) * PPITCH + (32 * ks + 8 * fq) * 2);
#pragma unroll
                for (int et = 0; et < 4; ++et)
#pragma unroll
                    for (int lt = 0; lt < 4; ++lt) acc[et][lt] = __builtin_amdgcn_mfma_f32_16x16x32_bf16(vf[et], pf[lt], acc[et][lt], 0, 0, 0);
            }
            if (odd) {
                const bf16_t* vp2 = vp - (size_t)8 * 512 * 64;
#pragma unroll
                for (int ks = 0; ks < 2; ++ks) {
                    bf16x8 vf[4], pf[4];
#pragma unroll
                    for (int et = 0; et < 4; ++et) vf[et] = *(const bf16x8*)(vp2 + (size_t)et * 16 * 64 + 32 * ks);
#pragma unroll
                    for (int lt = 0; lt < 4; ++lt) pf[lt] = *(const LAS bf16x8*)(Pl2 + (16 * lt + fr) * PPITCH + (32 * ks + 8 * fq) * 2);
#pragma unroll
                    for (int et = 0; et < 4; ++et)
#pragma unroll
                        for (int lt = 0; lt < 4; ++lt) acc[et][lt] = __builtin_amdgcn_mfma_f32_16x16x32_bf16(vf[et], pf[lt], acc[et][lt], 0, 0, 0);
                }
            }
        }
        { const int un = unit + (int)gridDim.x;
          if (un < NCH * RH) { const int c_ = un >> 3, h_ = un & 7;
#pragma unroll
              for (int i = 0; i < 4; ++i) { const int idx = tid + NTHREADS * i, row = idx >> 5, ch = idx & 31; qn[i] = *(const u32x4*)(Q + (size_t)(c_ * 64 + row) * 2048 + h_ * 256 + ch * 8); } } }
        u32x2 gpre[4][4]; f32x4 gvp[4];
#pragma unroll
        for (int et = 0; et < 4; ++et) { const int e = 64 * wave + 16 * et + 4 * fq; gvp[et] = *(const f32x4*)(gn + h * 512 + e);
#pragma unroll
            for (int lt = 0; lt < 4; ++lt) gpre[et][lt] = *(const u32x2*)(GO + (size_t)(t0 + 16 * lt + fr) * NVD + h * 512 + e); }
        float mu[4], rstd[4];
#pragma unroll
        for (int lt = 0; lt < 4; ++lt) { float s = 0.f;
#pragma unroll
            for (int et = 0; et < 4; ++et) s += (acc[et][lt][0] + acc[et][lt][1]) + (acc[et][lt][2] + acc[et][lt][3]);
            s += __shfl_xor(s, 16); s += __shfl_xor(s, 32);
            if (fq == 0) red[wave * 64 + 16 * lt + fr] = s; }
        __syncthreads();
#pragma unroll
        for (int lt = 0; lt < 4; ++lt) { float s = 0.f;
#pragma unroll
            for (int w = 0; w < 8; ++w) s += red[w * 64 + 16 * lt + fr];
            mu[lt] = s * (1.0f / 512.0f); }
#pragma unroll
        for (int lt = 0; lt < 4; ++lt) { float q = 0.f;
#pragma unroll
            for (int et = 0; et < 4; ++et) { const f32x4 dd = acc[et][lt] - mu[lt]; q += (dd[0] * dd[0] + dd[1] * dd[1]) + (dd[2] * dd[2] + dd[3] * dd[3]); }
            q += __shfl_xor(q, 16); q += __shfl_xor(q, 32);
            if (fq == 0) red[512 + wave * 64 + 16 * lt + fr] = q; }
        __syncthreads();
#pragma unroll
        for (int lt = 0; lt < 4; ++lt) { float q = 0.f;
#pragma unroll
            for (int w = 0; w < 8; ++w) q += red[512 + w * 64 + 16 * lt + fr];
            rstd[lt] = rsqrtf(q * (1.0f / 512.0f) + EPS); }
#pragma unroll
        for (int et = 0; et < 4; ++et) { const int e = 64 * wave + 16 * et + 4 * fq; const f32x4 gv = gvp[et];
#pragma unroll
            for (int lt = 0; lt < 4; ++lt) { bf16_t* gp = GO + (size_t)(t0 + 16 * lt + fr) * NVD + h * 512 + e; const u32x2 gw2 = gpre[et][lt];
                const f32x4 o = (acc[et][lt] - mu[lt]) * rstd[lt] * gv;
                u32x2 w; w.x = pk2(o[0] * bflo(gw2.x), o[1] * bfhi(gw2.x)); w.y = pk2(o[2] * bflo(gw2.y), o[3] * bfhi(gw2.y)); if (!dry) *(u32x2*)gp = w; } }
    }
}
constexpr int SSM_WLDS = 17664;
#define CBAR() asm volatile("s_waitcnt lgkmcnt(0)" ::: "memory")
template <int PASS> __device__ __forceinline__ void ssm_phase(int j, LAS unsigned char* lds, int lane, int wave) { KARGS;
    const int fr = lane & 15, fq = lane >> 4; const int gw = blockIdx.x * NWAVES + wave, NGW = gridDim.x * NWAVES;
    const int li = 2 * j + 1;
    const float* X = (const float*)(a.ws + WS_X); const float* rsp = (const float*)(a.ws + WS_RSP) + (size_t)(2 * li) * T * 64; float* Fb = (float*)(a.ws + WS_F);
    bf16_t* GL = (bf16_t*)(a.ws + WS_GL);
    LAS unsigned char* hL = lds + wave * SSM_WLDS; LAS unsigned char* buL = hL + 8192; LAS float* rsL = (LAS float*)(hL + 16384); LAS f32x4* cfL = (LAS f32x4*)(hL + 16640);
    const float* gmix = a.in[I_NMIX] + (size_t)li * D;
    for (int task = gw; task < 2048; task += NGW) {
        const int g = (((task >> 3) & 31) << 2) | (task & 3), rr_ = 2 * (task >> 8) + ((task >> 2) & 1), c_begin = 8 * rr_, sb_ = rr_ >> 1, nchunk = (PASS == 1 || (rr_ & 1)) ? 8 : 9;
        const int p = lane;
        const float dt = expf(a.in[I_LDT][j * 128 + g]);
        const float are = a.in[I_ARE][(size_t)(j * 128 + g) * 64 + p], aim = a.in[I_AIM][(size_t)(j * 128 + g) * 64 + p];
        const float xx = are * dt, yy = aim * dt, ex = expf(xx); float sy, cy; sincosf(yy, &sy, &cy);
        const float abr = ex * cy, abi = ex * sy;
        { const float sh = sinf(0.5f * yy); const float m1r = expm1f(xx) * cy - 2.0f * sh * sh, m1i = abi;
          const float inv = 1.0f / (are * are + aim * aim); const float cr = (m1r * are + m1i * aim) * inv, ci = (m1i * are - m1r * aim) * inv;
          cfL[p] = (f32x4){cr, ci, abr, abi}; }
        CBAR();
        float hr = 0.f, hi = 0.f;
        if (PASS == 3) {
            {
                float pr = abr, pi = abi;
#pragma unroll
                for (int s = 0; s < 6; ++s) { const float nr = pr * pr - pi * pi, ni = 2.0f * pr * pi; pr = nr; pi = ni; }
                for (int cp = 0; cp < c_begin; cp += 8) { f32x2 f[8];
#pragma unroll
                    for (int q = 0; q < 8; ++q) f[q] = *(const f32x2*)(Fb + ((size_t)((cp + q) * 128 + g) * 64 + p) * 2);
#pragma unroll
                    for (int q = 0; q < 8; ++q) { const float nr = pr * hr - pi * hi + f[q].x, ni = pr * hi + pi * hr + f[q].y; hr = nr; hi = ni; } }
            }
        }
        bf16x8 bfr[4], bfi[4];
#pragma unroll
        for (int pt = 0; pt < 4; ++pt) {
            const bf16x8 z = {0, 0, 0, 0, 0, 0, 0, 0}; bfr[pt] = z; bfi[pt] = z;
            if (fq < 2) {
                const int pp = 16 * pt + fr; const f32x4 cf4 = cfL[pp]; const float cr = cf4[0], ci = cf4[1];
                const float* br = a.in[I_BRE] + ((size_t)(j * 128 + g) * 64 + pp) * 16 + 8 * fq; const float* bi = a.in[I_BIM] + ((size_t)(j * 128 + g) * 64 + pp) * 16 + 8 * fq;
                const f32x4 r0 = *(const f32x4*)br, r1 = *(const f32x4*)(br + 4), i0 = *(const f32x4*)bi, i1 = *(const f32x4*)(bi + 4);
                const f32x4 g0 = *(const f32x4*)(gmix + 16 * g + 8 * fq), g1 = *(const f32x4*)(gmix + 16 * g + 8 * fq + 4);
                const f32x4 re0 = (r0 * cr - i0 * ci) * g0, re1 = (r1 * cr - i1 * ci) * g1, im0 = (i0 * cr + r0 * ci) * g0, im1 = (i1 * cr + r1 * ci) * g1;
                u32x4 w; w.x = pk2(re0[0], re0[1]); w.y = pk2(re0[2], re0[3]); w.z = pk2(re1[0], re1[1]); w.w = pk2(re1[2], re1[3]); bfr[pt] = __builtin_bit_cast(bf16x8, w);
                w.x = pk2(im0[0], im0[1]); w.y = pk2(im0[2], im0[3]); w.z = pk2(im1[0], im1[1]); w.w = pk2(im1[2], im1[3]); bfi[pt] = __builtin_bit_cast(bf16x8, w);
            }
        }
        bf16x8 cf[4]; float dd = 0.f;
        if (PASS == 3) {
            const float* cre = a.in[I_CRE] + ((size_t)(j * 128 + g) * 16 + fr) * 64 + 4 * fq; const float* cim = a.in[I_CIM] + ((size_t)(j * 128 + g) * 16 + fr) * 64 + 4 * fq;
#pragma unroll
            for (int ks = 0; ks < 4; ++ks) { const f32x4 vr = *(const f32x4*)(cre + 16 * ks), vi = *(const f32x4*)(cim + 16 * ks);
                u32x4 w; w.x = pk2(vr[0], -vi[0]); w.y = pk2(vr[1], -vi[1]); w.z = pk2(vr[2], -vi[2]); w.w = pk2(vr[3], -vi[3]); cf[ks] = __builtin_bit_cast(bf16x8, w); }
            dd = a.in[I_SD][(size_t)j * D + 16 * g + fr] * gmix[16 * g + fr];
        }
#pragma unroll 1
        for (int kc = 0; kc < nchunk; ++kc) {
            int c = c_begin + kc;
            if (kc == 8) {
                c = NPC + sb_;
                if (PASS == 3) { hr = a.in[I_SRE][((size_t)(j * 8 + sb_) * 128 + g) * 64 + p]; hi = a.in[I_SIM][((size_t)(j * 8 + sb_) * 128 + g) * 64 + p]; }
            }
            if (PASS == 1) { hr = 0.f; hi = 0.f; }
            { const int t = 64 * c + lane; float ssq = 0.f;
#pragma unroll
              for (int q = 0; q < 8; ++q) { const f32x4 v = *(const f32x4*)(rsp + (size_t)t * 64 + 4 * q); ssq += (v[0] + v[1]) + (v[2] + v[3]); }
              rsL[lane] = rsqrtf(ssq * (1.0f / D) + EPS); }
            CBAR();
#pragma unroll 1
            for (int half = 0; half < 2; ++half) {
#pragma unroll
                for (int lt = 0; lt < 2; ++lt) {
                    bf16x8 uf = {0, 0, 0, 0, 0, 0, 0, 0};
                    if (fq < 2) { const int l = 32 * half + 16 * lt + fr; const float rs = rsL[l]; const float* xp = X + (size_t)(64 * c + l) * D + 16 * g + 8 * fq;
                        const f32x4 x0 = *(const f32x4*)xp * rs, x1 = *(const f32x4*)(xp + 4) * rs;
                        u32x4 w; w.x = pk2(x0[0], x0[1]); w.y = pk2(x0[2], x0[3]); w.z = pk2(x1[0], x1[1]); w.w = pk2(x1[2], x1[3]); uf = __builtin_bit_cast(bf16x8, w); }
                    f32x4 dre[4], dim[4];
#pragma unroll
                    for (int pt = 0; pt < 4; ++pt) { const f32x4 z4 = {0.f, 0.f, 0.f, 0.f};
                        dre[pt] = __builtin_amdgcn_mfma_f32_16x16x32_bf16(uf, bfr[pt], z4, 0, 0, 0); dim[pt] = __builtin_amdgcn_mfma_f32_16x16x32_bf16(uf, bfi[pt], z4, 0, 0, 0); }
                    asm volatile("s_nop 15\n\ts_nop 15" : "+v"(dre[0]), "+v"(dre[1]), "+v"(dre[2]), "+v"(dre[3]), "+v"(dim[0]), "+v"(dim[1]), "+v"(dim[2]), "+v"(dim[3]));
#pragma unroll
                    for (int pt = 0; pt < 4; ++pt)
#pragma unroll
                        for (int r = 0; r < 4; ++r) *(LAS unsigned*)(buL + (16 * lt + 4 * fq + r) * 256 + 4 * (16 * pt + fr)) = pk2(dre[pt][r], dim[pt][r]);
                }
                CBAR();
#pragma unroll 1
                for (int l8 = 0; l8 < 32; l8 += 8) {
                    unsigned w[8];
#pragma unroll
                    for (int q = 0; q < 8; ++q) w[q] = *(const LAS unsigned*)(buL + (l8 + q) * 256 + 4 * p);
#pragma unroll
                    for (int q = 0; q < 8; ++q) {
                        const float nr = abr * hr - abi * hi + bflo(w[q]), ni = abr * hi + abi * hr + bfhi(w[q]); hr = nr; hi = ni;
                        if (PASS == 3) *(LAS unsigned*)(hL + (l8 + q) * 256 + ((((p >> 2) ^ ((l8 + q) & 15))) << 4) + (p & 3) * 4) = pk2(hr, hi);
                    }
                }
                CBAR();
                if (PASS == 3) {
#pragma unroll
                    for (int lt = 0; lt < 2; ++lt) {
                        f32x4 y = {0.f, 0.f, 0.f, 0.f};
#pragma unroll
                        for (int ks = 0; ks < 4; ++ks) { const bf16x8 hf = *(const LAS bf16x8*)(hL + (16 * lt + fr) * 256 + (((4 * ks + fq) ^ fr) << 4)); y = __builtin_amdgcn_mfma_f32_16x16x32_bf16(hf, cf[ks], y, 0, 0, 0); }
                        asm volatile("s_nop 15\n\ts_nop 15" : "+v"(y));
                        const int ch = 16 * g + fr;
#pragma unroll
                        for (int r = 0; r < 4; ++r) { const int l = 32 * half + 16 * lt + 4 * fq + r; const size_t t = (size_t)(64 * c + l);
                            const float v = y[r] + dd * X[t * D + ch] * rsL[l];
                            GL[t * D + ch] = (bf16_t)pk2(gelu_tanh(v), 0.f); }
                    }
                    CBAR();
                }
            }
            if (PASS == 1) { *(f32x2*)(Fb + ((size_t)(c * 128 + g) * 64 + p) * 2) = (f32x2){hr, hi}; }
            else {
                if (c == NPC - 1) { a.out[O_REP + (size_t)(j * 128 + g) * 64 + p] = hr; a.out[O_IMP + (size_t)(j * 128 + g) * 64 + p] = hi; }
                else if (c >= NPC) { const int b = c - NPC; a.out[O_RES + ((size_t)(j * 8 + b) * 128 + g) * 64 + p] = hr; a.out[O_IMS + ((size_t)(j * 8 + b) * 128 + g) * 64 + p] = hi; }
            }
            CBAR();
        }
    }
}

__device__ __forceinline__ void unpack8(const u32x4 w, float (&f)[8]) { f[0] = bflo(w.x); f[1] = bfhi(w.x); f[2] = bflo(w.y); f[3] = bfhi(w.y); f[4] = bflo(w.z); f[5] = bfhi(w.z); f[6] = bflo(w.w); f[7] = bfhi(w.w); }
__device__ __forceinline__ void conv_phase(int li, int tid) { KARGS;
    const bf16_t* A_ = (const bf16_t*)(a.ws + WS_A); const bf16_t* B_ = (const bf16_t*)(a.ws + WS_B); bf16_t* HM = (bf16_t*)(a.ws + WS_HM);
    const int col = tid * 8;
    float w0[8], w1[8], w2[8], cb[8];
    { const float* cw = a.in[I_CW] + (size_t)li * 3 * FF + col; const float* cbp = a.in[I_CB] + (size_t)li * FF + col;
#pragma unroll
      for (int e = 0; e < 8; ++e) { w0[e] = cw[e]; w1[e] = cw[FF + e]; w2[e] = cw[2 * FF + e]; cb[e] = cbp[e]; } }
#define CONV_LOAD(blk_, AR, BR) do { const int t0_ = (blk_) * 8, th_ = t0_ >= 2 ? t0_ - 2 : 0; \
        AR[0] = *(const u32x4*)(A_ + (size_t)th_ * FF + col); AR[1] = *(const u32x4*)(A_ + (size_t)(th_ + 1) * FF + col); \
        _Pragma("unroll") for (int r_ = 0; r_ < 8; ++r_) { AR[2 + r_] = *(const u32x4*)(A_ + (size_t)(t0_ + r_) * FF + col); BR[r_] = *(const u32x4*)(B_ + (size_t)(t0_ + r_) * FF + col); } } while (0)
#define CONV_COMPUTE(blk_, AR, BR) do { const int t0 = (blk_) * 8; float am2[8], am1[8]; \
        if (t0 == 0) { _Pragma("unroll") for (int e = 0; e < 8; ++e) { am2[e] = 0.f; am1[e] = 0.f; } } \
        else if (t0 >= TP && (t0 & 63) == 0) { const float* cp = a.in[I_CACHE] + ((size_t)(li * 8 + ((t0 - TP) >> 6)) * 2) * FF + col; \
            _Pragma("unroll") for (int e = 0; e < 8; ++e) { am2[e] = cp[e]; am1[e] = cp[FF + e]; } } \
        else { unpack8(AR[0], am2); unpack8(AR[1], am1); } \
        _Pragma("unroll") for (int r = 0; r < 8; ++r) { float av[8], bv[8]; unpack8(AR[2 + r], av); unpack8(BR[r], bv); float o[8]; \
            _Pragma("unroll") for (int e = 0; e < 8; ++e) { const float v = cb[e] + w0[e] * am2[e] + w1[e] * am1[e] + w2[e] * av[e]; o[e] = silu_f(v) * bv[e]; am2[e] = am1[e]; am1[e] = av[e]; } \
            u32x4 w; w.x = pk2(o[0], o[1]); w.y = pk2(o[2], o[3]); w.z = pk2(o[4], o[5]); w.w = pk2(o[6], o[7]); \
            *(u32x4*)(HM + (size_t)(t0 + r) * FF + col) = w; } } while (0)
    constexpr int NB = T / 8; const int G = gridDim.x;
    u32x4 ar0[10], br0[8], ar1[10], br1[8];
    int blk = blockIdx.x;
    if (blk < NB) CONV_LOAD(blk, ar0, br0);
    for (; blk < NB; blk += 2 * G) {
        const int blk2 = blk + G;
        if (blk2 < NB) CONV_LOAD(blk2, ar1, br1);
        CONV_COMPUTE(blk, ar0, br0);
        if (blk2 < NB) { if (blk2 + G < NB) CONV_LOAD(blk2 + G, ar0, br0); CONV_COMPUTE(blk2, ar1, br1); }
    }
#undef CONV_LOAD
#undef CONV_COMPUTE
}

__device__ __forceinline__ void final_phase(int lane, int wave) { KARGS;
    const float* X = (const float*)(a.ws + WS_X); const float* rsp = (const float*)(a.ws + WS_RSP) + (size_t)8 * T * 64; const float* nf = a.in[I_NFIN];
    const int gw = blockIdx.x * NWAVES + wave, NGW = gridDim.x * NWAVES;
    for (int t = gw; t < T; t += NGW) { const float rs = rsqrtf(wave_sum(lane < 32 ? rsp[(size_t)t * 64 + lane] : 0.f) * (1.0f / D) + EPS);
#pragma unroll
        for (int jj = 0; jj < 8; ++jj) { const int c = 4 * (lane + 64 * jj); __builtin_nontemporal_store(*(const f32x4*)(X + (size_t)t * D + c) * rs * *(const f32x4*)(nf + c), (f32x4*)(a.out + O_Y + (size_t)t * D + c)); } }
}

__device__ __forceinline__ void samp_reduce(int nidx, int lane, int wave) { KARGS;
    float* X = (float*)(a.ws + WS_X); bf16_t* XB = (bf16_t*)(a.ws + WS_XB); float* rsp = (float*)(a.ws + WS_RSP) + (size_t)nidx * T * 64; const float* P = (const float*)(a.ws + WS_P);
    const int gw = blockIdx.x * NWAVES + wave, NGW = gridDim.x * NWAVES;
    for (int it = gw; it < TS * 4; it += NGW) {
        const int r = it >> 2, q = it & 3, t = TP + r, col = q * 512 + lane * 8;
        f32x4 x0 = *(const f32x4*)(X + (size_t)t * D + col), x1 = *(const f32x4*)(X + (size_t)t * D + col + 4);
#pragma unroll
        for (int sl = 0; sl < 16; ++sl) { const float* pp = P + ((size_t)sl * TS + r) * D + col; x0 += *(const f32x4*)pp; x1 += *(const f32x4*)(pp + 4); }
        *(f32x4*)(X + (size_t)t * D + col) = x0; *(f32x4*)(X + (size_t)t * D + col + 4) = x1; store8bf(XB + (size_t)t * D + col, x0, x1);
        float ss = (x0[0] * x0[0] + x0[1] * x0[1]) + (x0[2] * x0[2] + x0[3] * x0[3]) + (x1[0] * x1[0] + x1[1] * x1[1]) + (x1[2] * x1[2] + x1[3] * x1[3]);
        ss = wave_sum(ss);
        if (lane < 8) rsp[(size_t)t * 64 + q * 8 + lane] = lane == 0 ? ss : 0.f;
    }
}

constexpr int N_PHASES = 34;
__global__ void __launch_bounds__(NTHREADS, 2) mega_fwd(Args a_unused) {
    extern __shared__ __attribute__((aligned(16))) unsigned char lds_raw[];
    LAS unsigned char* lds = (LAS unsigned char*)lds_raw;
    cg::grid_group grid = cg::this_grid();
    volatile LAS unsigned* bst = (volatile LAS unsigned*)(lds + LDS_BYTES - 64);
    if (threadIdx.x < 16) bst[threadIdx.x] = 0u;
    __syncthreads();
    int ph = 0; int ph_lo, ph_hi, coop; { KARGS; ph_lo = a.ph_lo; ph_hi = a.ph_hi; coop = a.coop; if (coop && blockIdx.x == 0) { unsigned* bw = (unsigned*)(a.ws + WS_BAR); for (int i = threadIdx.x; i < 4096; i += NTHREADS) bw[i] = 0u; } }
#ifndef EN_MASK
#define EN_MASK 0xfff
#endif
#define EN(k) (((EN_MASK) >> (k)) & 1)
#ifndef PROBE_REP
#define PROBE_REP 0
#endif
#define RP(k) for (int rr = 0; rr <= ((PROBE_REP >> (k)) & 1); ++rr)
#define PH_RUN (ph >= ph_lo && ph < ph_hi)
#define PH_LOCALS int tid = threadIdx.x; asm volatile("" : "+v"(tid)); const int lane = tid & 63, wave = __builtin_amdgcn_readfirstlane(tid >> 6); int li = li_; asm volatile("" : "+s"(li)); const int j = li >> 1, G = gridDim.x; (void)lane; (void)wave; (void)j; (void)G
#define PH_END do { ++ph; if (coop && ph > ph_lo && ph < ph_hi) { \
        if (ph == 1) { asm volatile("s_waitcnt vmcnt(0) lgkmcnt(0)" ::: "memory"); grid.sync(); (void)xcd_barrier_post((unsigned*)(kargs()->ws + WS_BAR), bst); }     \
        else { XcdBarrier xb_; xb_.bar = (unsigned*)(kargs()->ws + WS_BAR); xb_.x = xb_xcc_id(); xb_.st = bst; xcd_barrier(xb_); } } } while (0)
#define GEMM_PTRS KARGS; bf16_t* XB = (bf16_t*)(a.ws + WS_XB); (void)XB
    { const int li_ = 0; if (PH_RUN && EN(0)) RP(0) { PH_LOCALS; prologue(lds, tid, lane, wave); } }
    PH_END;
#pragma unroll 1
    for (int li_ = 0; li_ < 4; ++li_) {
        if ((li_ & 1) == 0) {
            if (PH_RUN && EN(1)) RP(1) {
                PH_LOCALS; GEMM_PTRS;
                pg8::Gemm g{XB, (const bf16_t*)(a.ws + WS_WIN) + (size_t)j * NIN * 2048, T, NIN, 2048}; pg8::StaticOrder S; S.init(T, NIN, G, (int)blockIdx.x, 2048);
                EpiRetIn E{a.ws, li};
                pg8::gemm_phase<EpiRetIn, pg8::StaticOrder, true, true>(lds, g, S, E);
            }
            PH_END;
            if (PH_RUN && EN(2)) RP(2) { PH_LOCALS; ret_scan_phase(j, lds, tid, lane, wave); }
            PH_END;
            if (PH_RUN && EN(3)) RP(3) { PH_LOCALS; ret_out_phase(j, lds, tid, lane, wave, rr); }
            PH_END;
            if (PH_RUN && EN(4)) RP(4) {
                PH_LOCALS; GEMM_PTRS;
                pg8::Gemm g{(const bf16_t*)(a.ws + WS_G), (const bf16_t*)(a.ws + WS_WOUT) + (size_t)j * 2048 * 4096, T, 2048, 4096}; pg8::ResOrder S; S.init(G, (int)blockIdx.x);
                EpiRes<false> E{a.ws, 2 * li + 1, rr};
                pg8::gemm_phase<EpiRes<false>, pg8::ResOrder, true, true>(lds, g, S, E);
            }
            PH_END;
            if (PH_RUN && EN(4)) { PH_LOCALS; samp_reduce(2 * li + 1, lane, wave); }
            PH_END;
        } else {
            if (PH_RUN && EN(5)) RP(5) { PH_LOCALS; ssm_phase<1>(j, lds, lane, wave); }
            PH_END;
            if (PH_RUN && EN(6)) RP(6) { PH_LOCALS; ssm_phase<3>(j, lds, lane, wave); }
            PH_END;
            if (PH_RUN && EN(7)) RP(7) {
                PH_LOCALS; GEMM_PTRS;
                pg8::Gemm g{(const bf16_t*)(a.ws + WS_GL), (const bf16_t*)(a.ws + WS_WGLU) + (size_t)j * 4096 * 2048, T, 4096, 2048}; pg8::StaticOrder S; S.init(T, 4096, G, (int)blockIdx.x, 2048);
                EpiRes<true> E{a.ws, 2 * li + 1, rr};
                pg8::gemm_phase<EpiRes<true>, pg8::StaticOrder, true, true>(lds, g, S, E);
            }
            PH_END;
        }
        if (PH_RUN && EN(8)) RP(8) {
            PH_LOCALS; GEMM_PTRS;
            pg8::Gemm g{XB, (const bf16_t*)(a.ws + WS_WUP) + (size_t)li * 8192 * 2048, T, 8192, 2048}; pg8::StaticOrder S; S.init(T, 8192, G, (int)blockIdx.x, 2048);
            EpiUp E{a.ws, a.out, li};
            pg8::gemm_phase<EpiUp, pg8::StaticOrder, true, true>(lds, g, S, E);
        }
        PH_END;
        if (PH_RUN && EN(9)) RP(9) { PH_LOCALS; conv_phase(li, tid); }
        PH_END;
        if (PH_RUN && EN(10)) RP(10) {
            PH_LOCALS; GEMM_PTRS;
            pg8::Gemm g{(const bf16_t*)(a.ws + WS_HM), (const bf16_t*)(a.ws + WS_WDN) + (size_t)li * 2048 * 4096, T, 2048, 4096}; pg8::ResOrder S; S.init(G, (int)blockIdx.x);
            EpiRes<false> E{a.ws, 2 * li + 2, rr};
            pg8::gemm_phase<EpiRes<false>, pg8::ResOrder, true, true>(lds, g, S, E);
        }
        PH_END;
        if (PH_RUN && EN(10)) { PH_LOCALS; samp_reduce(2 * li + 2, lane, wave); }
        PH_END;
    }
    { const int li_ = 0; if (PH_RUN && EN(11)) RP(11) { PH_LOCALS; final_phase(lane, wave); } }
#undef PH_RUN
#undef PH_END
}

#ifndef MK_SINGLE
#define MK_SINGLE 1
#endif
extern "C" void kernel_launch(void* const* d_in, const int* in_sizes, int n_in, void* d_out, int out_size, void* d_ws, size_t ws_size, hipStream_t stream) {
    static int grid = 0;
    if (grid == 0) {
        if (n_in != 25 || (size_t)out_size != O_END || ws_size < WS_END) { fprintf(stderr, "kernel_launch: unexpected shapes: n_in %d out %d ws %zu (need %zu)\n", n_in, out_size, ws_size, (size_t)WS_END); grid = -1; return; }
        int dev = 0, cus = 0, per_cu = 0;
        (void)hipGetDevice(&dev); (void)hipDeviceGetAttribute(&cus, hipDeviceAttributeMultiprocessorCount, dev);
        if (hipFuncSetAttribute((const void*)mega_fwd, hipFuncAttributeMaxDynamicSharedMemorySize, LDS_BYTES) != hipSuccess) { fprintf(stderr, "kernel_launch: hipFuncSetAttribute failed\n"); grid = -1; return; }
        if (hipOccupancyMaxActiveBlocksPerMultiprocessor(&per_cu, (const void*)mega_fwd, NTHREADS, LDS_BYTES) != hipSuccess || per_cu < 1) { fprintf(stderr, "kernel_launch: occupancy query gave %d\n", per_cu); per_cu = 1; }
        (void)hipGetLastError();
        grid = cus * per_cu; if (grid > 256) grid = 256; if (grid < 1) grid = 1;
    }
    if (grid < 0) return;
    Args a{};
    for (int i = 0; i < 25; ++i) a.in[i] = (const float*)d_in[i];
    a.out = (float*)d_out; a.ws = (unsigned char*)d_ws;
#if MK_SINGLE
    a.ph_lo = 0; a.ph_hi = N_PHASES; a.coop = 1;
    void* args[] = {&a};
    hipError_t e = hipLaunchCooperativeKernel((const void*)mega_fwd, dim3(grid), dim3(NTHREADS), args, LDS_BYTES, stream);
    if (e != hipSuccess) fprintf(stderr, "kernel_launch: cooperative launch failed: %s (grid %d)\n", hipGetErrorString(e), grid);
#else
    for (int p = 0; p < N_PHASES; ++p) { a.ph_lo = p; a.ph_hi = p + 1; a.coop = 0; hipLaunchKernelGGL(mega_fwd, dim3(grid), dim3(NTHREADS), LDS_BYTES, stream, a); }
#endif
}
```

```cpp
#include <hip/hip_runtime.h>
#include <hip/hip_cooperative_groups.h>
#include <cstdio>
#include <cstdint>
namespace cg = cooperative_groups;
namespace pg8 {
#define PG8_LAS __attribute__((address_space(3)))
typedef unsigned short bf16_t;
typedef short bf16x8 __attribute__((ext_vector_type(8)));
typedef float f32x4 __attribute__((ext_vector_type(4)));
typedef unsigned u32x4 __attribute__((ext_vector_type(4)));
constexpr int BM = 256, BK = 64, HALF = 128, HTB = HALF * BK * 2  , STAGE_BYTES = 8 * HTB, NXCD = 8, WGM = 8;

__host__ __device__ __forceinline__ int lds_byte(int r, int c) { const int st = (r >> 4) * 2 + (c >> 5), rr = r & 15, cc = c & 31, ob = rr * 64 + cc * 2; return st * 1024 + (ob ^ (((ob >> 9) & 1) << 5)); }
__host__ __device__ __forceinline__ void stage_rc(int b, int& R, int& C) { const int st = b / 1024, sb = b % 1024, swz = sb ^ (((sb >> 9) & 1) << 5); R = (st >> 1) * 16 + swz / 64; C = (st & 1) * 32 + (swz % 64) / 2; }
__host__ __device__ __forceinline__ int perm32(int rho) { const int n = rho >> 4, i = rho & 15; return 8 * (i >> 2) + 4 * n + (i & 3); }

struct Unit { int pm, pn, koff, nt; };
struct Gemm { const bf16_t* A; const bf16_t* Bt; int M, N, K; };

struct StaticOrder {
    int nM, nN, nwg, G, c, nt0;
    __host__ __device__ void init(int M, int N, int G_, int c_, int K_) { nM = M / BM; nN = N / BM; nwg = nM * nN; G = G_; c = c_; nt0 = K_ / BK; }
    __host__ __device__ bool next(int i, Unit& u) const {
        const long L = (long)i * G + c; if (L >= nwg) return false;
        int wgid = (int)L; { const int q = nwg / NXCD, r = nwg % NXCD, xcd = wgid % NXCD, off = wgid / NXCD; wgid = (xcd < r ? xcd * (q + 1) : r * (q + 1) + (xcd - r) * q) + off; }
        const int nig = WGM * nN, gid = wgid / nig, fm = gid * WGM, gsz = (nM - fm) < WGM ? (nM - fm) : WGM;
        u.pm = fm + ((wgid % nig) % gsz); u.pn = (wgid % nig) / gsz; u.koff = 0; u.nt = nt0; return true;
    }
    __device__ __forceinline__ void a_ready(const Unit&) const {}
    __device__ __forceinline__ void done(const Unit&) const {}
};
struct ResOrder {
    StaticOrder so; int G, c;
    __host__ __device__ void init(int G_, int c_) { so.init(8192, 2048, G_, c_, 4096); G = G_; c = c_; }
    __host__ __device__ bool next(int i, Unit& u) const {
        const int L = i * G + c; if (L >= 512) return false;
        if (L < 256) return so.next(i, u);
        const int s2 = L - 256, tile = s2 >> 4, sl = s2 & 15; u.pm = 32 + (tile >> 3); u.pn = tile & 7; u.koff = sl * 512; u.nt = 4; return true;
    }
    __device__ __forceinline__ void a_ready(const Unit&) const {}
    __device__ __forceinline__ void done(const Unit&) const {}
};
__device__ __forceinline__ unsigned cvt_pk_bf16(float lo, float hi) { unsigned r; asm volatile("v_cvt_pk_bf16_f32 %0, %1, %2" : "=v"(r) : "v"(lo), "v"(hi)); return r; }
typedef float f32x2 __attribute__((ext_vector_type(2)));
template <class Epi, class Sched, bool ALIGN_EPI = false, bool SP2 = false>
__device__ __forceinline__ void gemm_phase(PG8_LAS unsigned char* lds, const Gemm g, const Sched& S, const Epi& E) {
    int tid = threadIdx.x; asm volatile("" : "+v"(tid)); const int wid = __builtin_amdgcn_readfirstlane(tid >> 6), lane = tid & 63, wr = wid >> 2, wc = wid & 3, fr = lane & 15, fq = lane >> 4;
    const int K = g.K;
    unsigned voffA[2], voffB[2];
#pragma unroll
    for (int i = 0; i < 2; ++i) { int R, C; stage_rc(tid * 16 + i * 8192, R, C); const int Rb = Epi::PERM ? ((R & ~31) + perm32(R & 31)) : R;
        voffA[i] = (unsigned)(R * K + C) * 2u; voffB[i] = (unsigned)(Rb * K + C) * 2u; }
    const size_t kstep = (size_t)(BK * 2);
    const size_t hstep = (size_t)HALF * K * 2;
    const size_t tstep = 2 * hstep;
    const unsigned ldsw = (unsigned)wid * 1024u;
    const int aoff = lds_byte(wr * 64 + fr, fq * 8), boff = lds_byte(wc * 32 + fr, fq * 8);
#define PG8_SA(b, h) (((b) * 2 + (h)) * HTB)
#define PG8_SB(b, h) ((4 + (b) * 2 + (h)) * HTB)
#define PG8_STAGE(bufoff, gbase, voff) do { _Pragma("unroll") for (int _i = 0; _i < 2; ++_i) \
        __builtin_amdgcn_global_load_lds((const unsigned*)((const char*)(gbase) + (voff)[_i]), (PG8_LAS unsigned*)(lds + (bufoff) + ldsw + _i * 8192), 16, 0, 0); } while (0)
#define PG8_LDA(dst, b, h) do { _Pragma("unroll") for (int m = 0; m < 4; ++m) _Pragma("unroll") for (int k = 0; k < 2; ++k) dst[m][k] = *(const PG8_LAS bf16x8*)(lds + PG8_SA(b, h) + aoff + m * 2048 + k * 1024); } while (0)
#define PG8_LDB(dst, b, h) do { _Pragma("unroll") for (int n = 0; n < 2; ++n) _Pragma("unroll") for (int k = 0; k < 2; ++k) dst[n][k] = *(const PG8_LAS bf16x8*)(lds + PG8_SB(b, h) + boff + n * 2048 + k * 1024); } while (0)
#define PG8_MMA(ai, bj, At, Bt) do { __builtin_amdgcn_s_setprio(1); _Pragma("unroll") for (int m = 0; m < 4; ++m) _Pragma("unroll") for (int n = 0; n < 2; ++n) _Pragma("unroll") for (int k = 0; k < 2; ++k) \
        acc[ai][bj][m][n] = __builtin_amdgcn_mfma_f32_16x16x32_bf16(Bt[n][k], At[m][k], acc[ai][bj][m][n], 0, 0, 0); __builtin_amdgcn_s_setprio(0); } while (0)
#define PG8_WAIT_V(n) asm volatile("s_waitcnt vmcnt(" #n ")" ::: "memory")
#define PG8_WAIT_L(n) asm volatile("s_waitcnt lgkmcnt(" #n ")" ::: "memory")
#define PG8_BAR __builtin_amdgcn_s_barrier()
#define PG8_SCHED __builtin_amdgcn_sched_barrier(0)
    Unit cur, nxt; int ui = 0;
    if (!S.next(0, cur)) return;
    f32x4 acc[2][2][4][2];
#pragma unroll
    for (int a = 0; a < 2; ++a)
#pragma unroll
        for (int b = 0; b < 2; ++b)
#pragma unroll
            for (int m = 0; m < 4; ++m)
#pragma unroll
                for (int n = 0; n < 2; ++n) acc[a][b][m][n] = (f32x4){0.f, 0.f, 0.f, 0.f};
    bf16x8 At[4][2], B0[2][2], B1[2][2];
    const char* cA = (const char*)g.A + (size_t)cur.pm * tstep + cur.koff; const char* cB = (const char*)g.Bt + (size_t)cur.pn * tstep + cur.koff;
    S.a_ready(cur);
    if constexpr (SP2) {
        PG8_STAGE(PG8_SB(0, 0), cB, voffB); PG8_STAGE(PG8_SB(0, 1), cB + hstep, voffB); PG8_STAGE(PG8_SA(0, 0), cA, voffA); PG8_STAGE(PG8_SA(0, 1), cA + hstep, voffA);
        if (wr == 1) PG8_BAR;
        PG8_WAIT_V(2); PG8_BAR;
        PG8_STAGE(PG8_SB(1, 0), cB + kstep, voffB); PG8_STAGE(PG8_SA(1, 0), cA + kstep, voffA); PG8_STAGE(PG8_SB(1, 1), cB + hstep + kstep, voffB);
        PG8_WAIT_V(6); PG8_BAR;
    } else {
        PG8_STAGE(PG8_SB(0, 0), cB, voffB); PG8_STAGE(PG8_SA(0, 0), cA, voffA); PG8_STAGE(PG8_SB(0, 1), cB + hstep, voffB); PG8_STAGE(PG8_SA(0, 1), cA + hstep, voffA);
        if (wr == 1) PG8_BAR;
        PG8_WAIT_V(4); PG8_BAR;
        PG8_STAGE(PG8_SB(1, 0), cB + kstep, voffB); PG8_STAGE(PG8_SA(1, 0), cA + kstep, voffA); PG8_STAGE(PG8_SB(1, 1), cB + hstep + kstep, voffB);
        PG8_WAIT_V(6); PG8_BAR;
    }
    for (;;) {
        const bool has_next = S.next(ui + 1, nxt);
        const char* nA = has_next ? (const char*)g.A + (size_t)nxt.pm * tstep + nxt.koff : cA; const char* nB = has_next ? (const char*)g.Bt + (size_t)nxt.pn * tstep + nxt.koff : cB;
        const int nt = cur.nt;
        for (int t = 0; t < nt; t += 2) {
            const bool last = (t == nt - 2);
            const char* a1 = cA + (size_t)(t + 1) * kstep;
            const char* a2 = last ? nA : cA + (size_t)(t + 2) * kstep; const char* b2 = last ? nB : cB + (size_t)(t + 2) * kstep;
            const char* a3 = a2 + kstep; const char* b3 = b2 + kstep;
            if (last && has_next) S.a_ready(nxt);
            if constexpr (SP2) {
            PG8_LDB(B0, 0, 0); PG8_LDB(B1, 0, 1); PG8_SCHED; PG8_LDA(At, 0, 0); PG8_STAGE(PG8_SA(1, 1), a1 + hstep, voffA);
            PG8_WAIT_V(8); PG8_WAIT_L(0); PG8_BAR; PG8_MMA(0, 0, At, B0); PG8_MMA(0, 1, At, B1); PG8_BAR; PG8_SCHED;
            PG8_LDA(At, 0, 1); PG8_STAGE(PG8_SB(0, 0), b2, voffB); PG8_STAGE(PG8_SB(0, 1), b2 + hstep, voffB); PG8_STAGE(PG8_SA(0, 0), a2, voffA);
            PG8_WAIT_V(8); PG8_WAIT_L(0); PG8_BAR; PG8_MMA(1, 0, At, B0); PG8_MMA(1, 1, At, B1); PG8_BAR; PG8_SCHED;
            PG8_LDB(B0, 1, 0); PG8_LDB(B1, 1, 1); PG8_SCHED; PG8_LDA(At, 1, 0); PG8_STAGE(PG8_SA(0, 1), a2 + hstep, voffA);
            PG8_WAIT_V(8); PG8_WAIT_L(0); PG8_BAR; PG8_MMA(0, 0, At, B0); PG8_MMA(0, 1, At, B1); PG8_BAR; PG8_SCHED;
            PG8_LDA(At, 1, 1); PG8_STAGE(PG8_SB(1, 0), b3, voffB); PG8_STAGE(PG8_SB(1, 1), b3 + hstep, voffB); PG8_STAGE(PG8_SA(1, 0), a3, voffA);
            PG8_WAIT_V(8); PG8_WAIT_L(0); PG8_BAR; PG8_MMA(1, 0, At, B0); PG8_MMA(1, 1, At, B1); PG8_BAR; PG8_SCHED;
            } else {
            PG8_LDB(B0, 0, 0); PG8_SCHED; PG8_LDA(At, 0, 0); PG8_STAGE(PG8_SA(1, 1), a1 + hstep, voffA);
            PG8_WAIT_L(8); PG8_BAR; PG8_WAIT_L(0); PG8_MMA(0, 0, At, B0); PG8_BAR; PG8_SCHED;
            PG8_LDB(B1, 0, 1); PG8_STAGE(PG8_SB(0, 0), b2, voffB);
            PG8_BAR; PG8_WAIT_L(0); PG8_MMA(0, 1, At, B1); PG8_BAR;
            PG8_LDA(At, 0, 1); PG8_STAGE(PG8_SA(0, 0), a2, voffA);
            PG8_BAR; PG8_WAIT_L(0); PG8_MMA(1, 0, At, B0); PG8_BAR; PG8_SCHED;
            PG8_STAGE(PG8_SB(0, 1), b2 + hstep, voffB);
            PG8_WAIT_V(6); PG8_BAR; PG8_MMA(1, 1, At, B1); PG8_BAR;
            PG8_LDB(B0, 1, 0); PG8_SCHED; PG8_LDA(At, 1, 0); PG8_STAGE(PG8_SA(0, 1), a2 + hstep, voffA);
            PG8_WAIT_L(8); PG8_BAR; PG8_WAIT_L(0); PG8_MMA(0, 0, At, B0); PG8_BAR; PG8_SCHED;
            PG8_LDB(B1, 1, 1); PG8_STAGE(PG8_SB(1, 0), b3, voffB);
            PG8_BAR; PG8_WAIT_L(0); PG8_MMA(0, 1, At, B1); PG8_BAR;
            PG8_LDA(At, 1, 1); PG8_STAGE(PG8_SA(1, 0), a3, voffA);
            PG8_BAR; PG8_WAIT_L(0); PG8_MMA(1, 0, At, B0); PG8_BAR; PG8_SCHED;
            PG8_STAGE(PG8_SB(1, 1), b3 + hstep, voffB);
            PG8_WAIT_V(6); PG8_BAR; PG8_MMA(1, 1, At, B1); PG8_BAR;
            }
        }
        if constexpr (ALIGN_EPI) { if (wr == 0) PG8_BAR; }
        if constexpr (!Epi::AFTER_DRAIN) { E(acc, cur, wr, wc, fr, fq); S.done(cur); }
        if (!has_next) break;
#pragma unroll
        for (int a = 0; a < 2; ++a)
#pragma unroll
            for (int b = 0; b < 2; ++b)
#pragma unroll
                for (int m = 0; m < 4; ++m)
#pragma unroll
                    for (int n = 0; n < 2; ++n) acc[a][b][m][n] = (f32x4){0.f, 0.f, 0.f, 0.f};
        cur = nxt; cA = nA; cB = nB; ++ui;
        if constexpr (ALIGN_EPI) { if (wr == 1) PG8_BAR; }
    }
    PG8_WAIT_V(0);
    if constexpr (!ALIGN_EPI) { if (wr == 0) PG8_BAR; }
    PG8_BAR;
    if constexpr (Epi::AFTER_DRAIN) { E.fused(acc, cur, wr, wc, fr, fq, lds, wid, lane); S.done(cur); }
#undef PG8_SA
#undef PG8_SB
#undef PG8_STAGE
#undef PG8_LDA
#undef PG8_LDB
#undef PG8_MMA
#undef PG8_WAIT_V
#undef PG8_WAIT_L
#undef PG8_BAR
#undef PG8_SCHED
}
}
constexpr int D = 2048, TP = 8192, TS = 512, T = TP + TS, NCH = T / 64, NPC = TP / 64;
constexpr int RH = 8, DK = 256, DV = 512, NIN = 12288, NVD = 4096;
constexpr int FF = 4096;
constexpr float EPS = 1e-6f;
constexpr int NTHREADS = 512, NWAVES = 8;
constexpr int LDS_BYTES = 147456;

#define LAS __attribute__((address_space(3)))
typedef unsigned short bf16_t;
typedef short bf16x8 __attribute__((ext_vector_type(8)));
typedef float f32x4 __attribute__((ext_vector_type(4)));
typedef float f32x2 __attribute__((ext_vector_type(2)));
typedef unsigned u32x4 __attribute__((ext_vector_type(4)));
typedef unsigned u32x2 __attribute__((ext_vector_type(2)));

constexpr size_t MiB = 1u << 20;
constexpr size_t WS_BAR = 0;
constexpr size_t WS_RSS = 0;
constexpr size_t WS_COS = 1 * MiB, WS_SIN = 5 * MiB;
constexpr size_t WS_F = 9 * MiB;
constexpr size_t WS_X = 18 * MiB;
constexpr size_t WS_XB = 86 * MiB;
constexpr size_t WS_WIN = 120 * MiB, WS_WOUT = 216 * MiB, WS_WGLU = 248 * MiB, WS_WUP = 280 * MiB, WS_WDN = 408 * MiB;
constexpr size_t WS_Q = 472 * MiB, WS_K = 506 * MiB, WS_KT = 540 * MiB, WS_VT = 574 * MiB, WS_G = 642 * MiB;
constexpr size_t WS_ST = 710 * MiB;
constexpr size_t WS_A = 710 * MiB, WS_B = 778 * MiB, WS_HM = 846 * MiB;
constexpr size_t WS_P = WS_Q;
constexpr size_t WS_GL = WS_Q;
constexpr size_t WS_RSP = 982 * MiB;
constexpr size_t WS_END = 1004 * MiB;

constexpr size_t O_Y = 0, O_RETP = 17825792, O_RETS = 19922944, O_REP = 36700160, O_IMP = 36716544, O_RES = 36732928, O_IMS = 36864000, O_CVP = 36995072, O_CVS = 37027840, O_END = 37289984;

struct Args { const float* in[25]; float* out; unsigned char* ws; int ph_lo, ph_hi, coop, pad; };
typedef const __attribute__((address_space(4))) Args KArgs;
__device__ __forceinline__ KArgs* kargs() { KArgs* p = (KArgs*)__builtin_amdgcn_kernarg_segment_ptr(); asm volatile("" : "+s"(p)); return p; }
#define KARGS KArgs& a = *kargs()
enum { I_XP = 0, I_XS, I_SRET, I_SRE, I_SIM, I_CACHE, I_NMIX, I_NFFN, I_NFIN, I_WIN, I_GN, I_WOUT, I_ARE, I_AIM, I_LDT, I_BRE, I_BIM, I_CRE, I_CIM, I_SD, I_WGLU, I_WUP, I_CW, I_CB, I_WDN };

__device__ __forceinline__ unsigned f2bf(float f) { unsigned u = __builtin_bit_cast(unsigned, f); return (u + 0x7fffu + ((u >> 16) & 1u)) >> 16; }
typedef __bf16 bf16x2_t __attribute__((ext_vector_type(2)));
__device__ __forceinline__ unsigned pk2(float lo, float hi) { const f32x2 v = {lo, hi}; const bf16x2_t b = __builtin_convertvector(v, bf16x2_t); return __builtin_bit_cast(unsigned, b); }
__device__ __forceinline__ float bflo(unsigned w) { return __builtin_bit_cast(float, w << 16); }
__device__ __forceinline__ float bfhi(unsigned w) { return __builtin_bit_cast(float, w & 0xffff0000u); }
__device__ __forceinline__ void store8bf(bf16_t* p, f32x4 a, f32x4 b) { u32x4 w; w.x = pk2(a[0], a[1]); w.y = pk2(a[2], a[3]); w.z = pk2(b[0], b[1]); w.w = pk2(b[2], b[3]); *(u32x4*)p = w; }
__device__ __forceinline__ float log2gamma(int h) { return log1pf(-exp2f(-5.0f - (float)h)) * 1.4426950408889634f; }
__device__ __forceinline__ float silu_f(float v) { return v / (1.0f + __expf(-v)); }
__device__ __forceinline__ float sigmoid_f(float v) { return 1.0f / (1.0f + __expf(-v)); }
__device__ __forceinline__ float gelu_tanh(float v) { const float z = 0.7978845608028654f * (v + 0.044715f * v * v * v); return v * (1.0f - 1.0f / (1.0f + __expf(2.0f * z))); }
__device__ __forceinline__ float wave_sum(float v) {
#pragma unroll
    for (int o = 1; o < 64; o <<= 1) v += __shfl_xor(v, o);
    return v;
}

__device__ __forceinline__ float row_rstd(const float* rsp, int t, int n4, int fq) {
    const f32x4* p = (const f32x4*)(rsp + (size_t)t * 64) + fq * n4; float s = 0.f;
    for (int i = 0; i < n4; ++i) { const f32x4 v = p[i]; s += (v[0] + v[1]) + (v[2] + v[3]); }
    s += __shfl_xor(s, 16); s += __shfl_xor(s, 32);
    return rsqrtf(s * (1.0f / D) + EPS);
}
struct EpiRetIn {
    static constexpr bool PERM = true, AFTER_DRAIN = false;
    unsigned char* ws; int li;
    __device__ __forceinline__ void operator()(const f32x4 (&acc)[2][2][4][2], const pg8::Unit& u, int wr, int wc, int fr, int fq) const {
        const float* rsp = (const float*)(ws + WS_RSP) + (size_t)(2 * li) * T * 64; const float* cosT = (const float*)(ws + WS_COS); const float* sinT = (const float*)(ws + WS_SIN);
        bf16_t* Q = (bf16_t*)(ws + WS_Q); bf16_t* K = (bf16_t*)(ws + WS_K); bf16_t* KT = (bf16_t*)(ws + WS_KT); bf16_t* VT = (bf16_t*)(ws + WS_VT); bf16_t* G = (bf16_t*)(ws + WS_G);
        const int pn = u.pn, rowb = u.pm * 256 + wr * 64 + fr, cl = wc * 32 + 8 * fq;
        if (pn < 16) {
            const bool isk = pn >= 8; const int h = pn & 7; const float l2g = log2gamma(h);
            bf16_t* dst = (isk ? K : Q) + h * 256 + cl;
#pragma unroll
            for (int ai = 0; ai < 2; ++ai)
#pragma unroll
                for (int m = 0; m < 4; ++m) {
                    const int t = rowb + ai * 128 + m * 16;
                    float rs = row_rstd(rsp, t, 2, fq); if (isk) rs *= 0.0625f;
                    const int pos = t < TP ? t : 1024 + (t & 63);
                    const f32x4 c0 = *(const f32x4*)(cosT + pos * 128 + cl), c1 = *(const f32x4*)(cosT + pos * 128 + cl + 4);
                    const f32x4 s0 = *(const f32x4*)(sinT + pos * 128 + cl), s1 = *(const f32x4*)(sinT + pos * 128 + cl + 4);
                    const f32x4 x1a = acc[ai][0][m][0] * rs, x1b = acc[ai][0][m][1] * rs, x2a = acc[ai][1][m][0] * rs, x2b = acc[ai][1][m][1] * rs;
                    const f32x4 o1a = x1a * c0 - x2a * s0, o1b = x1b * c1 - x2b * s1, o2a = x1a * s0 + x2a * c0, o2b = x1b * s1 + x2b * c1;
                    store8bf(dst + (size_t)t * 2048, o1a, o1b); store8bf(dst + (size_t)t * 2048 + 128, o2a, o2b);
                    if (isk) {
                        const int chunk = t >> 6, l = t & 63; const float dec = exp2f((float)(63 - l) * l2g);
                        bf16_t* kt = KT + ((size_t)(chunk * 8 + h) * 256 + cl) * 64 + l;
#pragma unroll
                        for (int jj = 0; jj < 4; ++jj) { kt[jj * 64] = (bf16_t)f2bf(o1a[jj] * dec); kt[(4 + jj) * 64] = (bf16_t)f2bf(o1b[jj] * dec);
                            kt[(128 + jj) * 64] = (bf16_t)f2bf(o2a[jj] * dec); kt[(132 + jj) * 64] = (bf16_t)f2bf(o2b[jj] * dec); }
                    }
                }
        } else if (pn < 32) {
            const int pv = pn - 16, h = pv >> 1, eb = (pv & 1) * 256 + cl;
#pragma unroll
            for (int ai = 0; ai < 2; ++ai)
#pragma unroll
                for (int m = 0; m < 4; ++m) {
                    const int t = rowb + ai * 128 + m * 16; const float rs = row_rstd(rsp, t, 2, fq);
                    const int chunk = t >> 6, l = t & 63;
                    bf16_t* vt = VT + ((size_t)(chunk * 8 + h) * 512 + eb) * 64 + l;
#pragma unroll
                    for (int bj = 0; bj < 2; ++bj)
#pragma unroll
                        for (int n = 0; n < 2; ++n)
#pragma unroll
                            for (int jj = 0; jj < 4; ++jj) vt[(bj * 128 + 4 * n + jj) * 64] = (bf16_t)f2bf(acc[ai][bj][m][n][jj] * rs);
                }
        } else {
            const int gcol = (pn - 32) * 256 + cl;
#pragma unroll
            for (int ai = 0; ai < 2; ++ai)
#pragma unroll
                for (int m = 0; m < 4; ++m) {
                    const int t = rowb + ai * 128 + m * 16; const float rs = row_rstd(rsp, t, 2, fq);
#pragma unroll
                    for (int bj = 0; bj < 2; ++bj) { f32x4 v0 = acc[ai][bj][m][0] * rs, v1 = acc[ai][bj][m][1] * rs;
#pragma unroll
                        for (int jj = 0; jj < 4; ++jj) { v0[jj] = silu_f(v0[jj]); v1[jj] = silu_f(v1[jj]); }
                        store8bf(G + (size_t)t * NVD + gcol + bj * 128, v0, v1); }
                }
        }
    }
};

template <bool GLU> struct EpiRes {
    static constexpr bool PERM = true, AFTER_DRAIN = false;
    unsigned char* ws; int nidx; int dry;
    __device__ __forceinline__ void operator()(const f32x4 (&acc)[2][2][4][2], const pg8::Unit& u, int wr, int wc, int fr, int fq) const {
        float* X = (float*)(ws + WS_X); bf16_t* XB = (bf16_t*)(ws + WS_XB); float* rsp_next = (float*)(ws + WS_RSP) + (size_t)nidx * T * 64;
        if (!GLU && u.nt == 4) {
            float* P = (float*)(ws + WS_P) + (size_t)(u.koff >> 9) * TS * D;
            const int rowp = (u.pm - TP / 256) * 256 + wr * 64 + fr, colp = u.pn * 256 + wc * 32 + 8 * fq;
#pragma unroll
            for (int ai = 0; ai < 2; ++ai)
#pragma unroll
                for (int m = 0; m < 4; ++m) { int rr_ = rowp + ai * 128 + m * 16; asm volatile("" : "+v"(rr_)); float* pr = P + (size_t)rr_ * D + colp;
#pragma unroll
                    for (int bj = 0; bj < 2; ++bj) { *(f32x4*)(pr + bj * 128) = acc[ai][bj][m][0]; *(f32x4*)(pr + bj * 128 + 4) = acc[ai][bj][m][1]; } }
            return;
        }
        const int rowb = u.pm * 256 + wr * 64 + fr, colb = u.pn * (GLU ? 128 : 256) + wc * 32 + 8 * fq;
#pragma unroll
        for (int ai = 0; ai < 2; ++ai)
#pragma unroll
            for (int m = 0; m < 4; ++m) {
                const int t = rowb + ai * 128 + m * 16; float ss = 0.f;
                float* xr = X + (size_t)t * D + colb; bf16_t* xbr = XB + (size_t)t * D + colb;
                if (GLU) {
                    f32x4 y0, y1;
#pragma unroll
                    for (int jj = 0; jj < 4; ++jj) { y0[jj] = acc[ai][0][m][0][jj] * sigmoid_f(acc[ai][1][m][0][jj]); y1[jj] = acc[ai][0][m][1][jj] * sigmoid_f(acc[ai][1][m][1][jj]); }
                    const f32x4 x0 = *(const f32x4*)xr + y0, x1 = *(const f32x4*)(xr + 4) + y1;
                    if (!dry) { *(f32x4*)xr = x0; *(f32x4*)(xr + 4) = x1; store8bf(xbr, x0, x1); }
                    ss += (x0[0] * x0[0] + x0[1] * x0[1]) + (x0[2] * x0[2] + x0[3] * x0[3]) + (x1[0] * x1[0] + x1[1] * x1[1]) + (x1[2] * x1[2] + x1[3] * x1[3]);
                } else {
#pragma unroll
                    for (int bj = 0; bj < 2; ++bj) {
                        const f32x4 x0 = *(const f32x4*)(xr + bj * 128) + acc[ai][bj][m][0], x1 = *(const f32x4*)(xr + bj * 128 + 4) + acc[ai][bj][m][1];
                        if (!dry) { *(f32x4*)(xr + bj * 128) = x0; *(f32x4*)(xr + bj * 128 + 4) = x1; store8bf(xbr + bj * 128, x0, x1); }
                        ss += (x0[0] * x0[0] + x0[1] * x0[1]) + (x0[2] * x0[2] + x0[3] * x0[3]) + (x1[0] * x1[0] + x1[1] * x1[1]) + (x1[2] * x1[2] + x1[3] * x1[3]);
                    }
                }
                ss += __shfl_xor(ss, 16); ss += __shfl_xor(ss, 32);
                if (fq == 0 && !dry) rsp_next[(size_t)t * 64 + u.pn * 4 + wc] = ss;
            }
    }
};

struct EpiUp {
    static constexpr bool PERM = true, AFTER_DRAIN = false;
    unsigned char* ws; float* out; int li;
    __device__ __forceinline__ void operator()(const f32x4 (&acc)[2][2][4][2], const pg8::Unit& u, int wr, int wc, int fr, int fq) const {
        const float* rsp = (const float*)(ws + WS_RSP) + (size_t)(2 * li + 1) * T * 64; const int n4 = (li & 1) ? 4 : 2; bf16_t* A_ = (bf16_t*)(ws + WS_A); bf16_t* B_ = (bf16_t*)(ws + WS_B);
        float* cvp = out + O_CVP + (size_t)li * 2 * FF; float* cvs = out + O_CVS + (size_t)li * 16 * FF;
        const int pn = u.pn, rowb = u.pm * 256 + wr * 64 + fr, colb = (pn & 15) * 256 + wc * 32 + 8 * fq; const bool isb = pn >= 16;
        bf16_t* dst = (isb ? B_ : A_) + colb;
#pragma unroll
        for (int ai = 0; ai < 2; ++ai)
#pragma unroll
            for (int m = 0; m < 4; ++m) {
                const int t = rowb + ai * 128 + m * 16; const float rs = row_rstd(rsp, t, n4, fq);
                float* cp = nullptr;
                if (!isb) { if (t >= TP - 2 && t < TP) cp = cvp + (size_t)(t - (TP - 2)) * FF + colb; else if (t >= TP && (t & 63) >= 62) cp = cvs + (size_t)(((t - TP) >> 6) * 2 + (t & 63) - 62) * FF + colb; }
#pragma unroll
                for (int bj = 0; bj < 2; ++bj) { const f32x4 v0 = acc[ai][bj][m][0] * rs, v1 = acc[ai][bj][m][1] * rs;
                    store8bf(dst + (size_t)t * FF + bj * 128, v0, v1);
                    if (cp) { *(f32x4*)(cp + bj * 128) = v0; *(f32x4*)(cp + bj * 128 + 4) = v1; } }
            }
    }
};
#define XB_TMO      128
#define XB_XCNT(j)  (256  + 64 * (j))
#define XB_XSUB(j)  (1280 + 64 * (j))
#define XB_XGEN(j)  (2304 + 64 * (j))
#define XB_TOP      3328
#define XB_TOPGEN   3392
#define XCD_BAR_WORDS 3456
#define XB_SPIN_CAP (1u << 18)

__device__ __forceinline__ unsigned xb_ld(unsigned* p)              { return __hip_atomic_load(p, __ATOMIC_RELAXED, __HIP_MEMORY_SCOPE_AGENT); }
__device__ __forceinline__ unsigned xb_add(unsigned* p, unsigned v) { return __hip_atomic_fetch_add(p, v, __ATOMIC_RELAXED, __HIP_MEMORY_SCOPE_AGENT); }
__device__ __forceinline__ unsigned xb_xcc_id() { return (unsigned)__builtin_amdgcn_s_getreg((3 << 11) | 20) & 0xFu; }
#define XB_SPIN(cond, bar) do { unsigned _sp = 0; while (cond) { __builtin_amdgcn_s_sleep(1); \
    if ((++_sp & 255u) == 0u) { if (xb_ld(&(bar)[XB_TMO])) break; if (_sp > XB_SPIN_CAP) { atomicAdd(&(bar)[XB_TMO], 1u); break; } } } } while (0)

struct XcdBarrier {
    unsigned* bar; unsigned x;
    volatile LAS unsigned* st;
};

__device__ __forceinline__ XcdBarrier xcd_barrier_post(unsigned* bar, volatile LAS unsigned* st) {
    XcdBarrier b; b.bar = bar; b.x = xb_xcc_id(); b.st = st;
    if (threadIdx.x == 0) (void)xb_add(&bar[XB_XCNT(b.x)], 1u);
    return b;
}
__device__ __forceinline__ void xcd_barrier_complete(unsigned* bar, unsigned x, unsigned& nloc, unsigned& nx) {
    const unsigned G = gridDim.x * gridDim.y * gridDim.z;
    unsigned sum, cnt, mine, sp = 0u;
    for (;;) {
        sum = 0u; cnt = 0u; mine = 0u;
#pragma unroll
        for (unsigned j = 0; j < 16; ++j) { const unsigned c = xb_ld(&bar[XB_XCNT(j)]); sum += c; cnt += (c > 0u) ? 1u : 0u; mine = (j == x) ? c : mine; }
        if (sum == G) break;
        __builtin_amdgcn_s_sleep(1);
        if ((++sp & 255u) == 0u) { if (xb_ld(&bar[XB_TMO])) break; if (sp > XB_SPIN_CAP) { atomicAdd(&bar[XB_TMO], 1u); break; } }
    }
    nloc = mine > 0u ? mine : 1u; nx = cnt > 0u ? cnt : 1u;
}

__device__ __forceinline__ void xcd_barrier(const XcdBarrier& b) {
    asm volatile("s_waitcnt vmcnt(0)" ::: "memory");
    __syncthreads();
    if (threadIdx.x == 0) {
        unsigned* bar = b.bar;
        __builtin_amdgcn_s_waitcnt(0);
        unsigned nloc = b.st[0], nx = b.st[1];
        if (nloc == 0u) { xcd_barrier_complete(bar, b.x, nloc, nx); b.st[0] = nloc; b.st[1] = nx; }
        const unsigned old = xb_add(&bar[XB_XSUB(b.x)], 1u);
        const unsigned gen = old / nloc;
        if (old + 1u == (gen + 1u) * nloc) {
            __builtin_amdgcn_fence(__ATOMIC_RELEASE, "agent");
            asm volatile("s_waitcnt vmcnt(0)" ::: "memory");
            const unsigned og = xb_add(&bar[XB_TOP], 1u);
            const unsigned tg = og / nx;
            if (og + 1u == (tg + 1u) * nx) xb_add(&bar[XB_TOPGEN], 1u);
            else XB_SPIN(xb_ld(&bar[XB_TOPGEN]) == tg, bar);
            __builtin_amdgcn_fence(__ATOMIC_ACQUIRE, "agent");
            xb_add(&bar[XB_XGEN(b.x)], 1u);
            asm volatile("s_waitcnt vmcnt(0)" ::: "memory");
        } else {
            XB_SPIN(xb_ld(&bar[XB_XGEN(b.x)]) == gen, bar);
            __builtin_amdgcn_fence(__ATOMIC_ACQUIRE, "agent");
            asm volatile("s_waitcnt vmcnt(0)" ::: "memory");
        }
    }
    __syncthreads();
}
struct WTile { const float* W; bf16_t* Wt; const float* ks; int K, N, k0, n0, mode; };
__device__ __forceinline__ WTile decode_tile(int it) { KARGS;
    WTile w; int r, nt;
    if (it < 3072) { const int j = it / 1536; r = it % 1536; nt = 48; w.K = 2048; w.N = NIN; w.W = a.in[I_WIN] + (size_t)j * 2048 * NIN; w.Wt = (bf16_t*)(a.ws + WS_WIN) + (size_t)j * NIN * 2048; w.ks = a.in[I_NMIX] + (2 * j) * D; w.mode = 0; }
    else if (it < 4096) { it -= 3072; const int j = it / 512; r = it % 512; nt = 8; w.K = 4096; w.N = 2048; w.W = a.in[I_WOUT] + (size_t)j * 4096 * 2048; w.Wt = (bf16_t*)(a.ws + WS_WOUT) + (size_t)j * 2048 * 4096; w.ks = nullptr; w.mode = 0; }
    else if (it < 5120) { it -= 4096; const int j = it / 512; r = it % 512; nt = 16; w.K = 2048; w.N = 4096; w.W = a.in[I_WGLU] + (size_t)j * 2048 * 4096; w.Wt = (bf16_t*)(a.ws + WS_WGLU) + (size_t)j * 4096 * 2048; w.ks = nullptr; w.mode = 1; }
    else if (it < 9216) { it -= 5120; const int i = it / 1024; r = it % 1024; nt = 32; w.K = 2048; w.N = 8192; w.W = a.in[I_WUP] + (size_t)i * 2048 * 8192; w.Wt = (bf16_t*)(a.ws + WS_WUP) + (size_t)i * 8192 * 2048; w.ks = a.in[I_NFFN] + i * D; w.mode = 0; }
    else { it -= 9216; const int i = it / 512; r = it % 512; nt = 8; w.K = 4096; w.N = 2048; w.W = a.in[I_WDN] + (size_t)i * 4096 * 2048; w.Wt = (bf16_t*)(a.ws + WS_WDN) + (size_t)i * 2048 * 4096; w.ks = nullptr; w.mode = 0; }
    w.k0 = (r / nt) * 64; w.n0 = (r % nt) * 256; return w;
}
constexpr int N_WTILES = 11264, TPITCH = 520;
__device__ __forceinline__ void tile_load(const WTile& w, int lane, int wave, f32x4 (&v)[8]) {
#pragma unroll
    for (int i = 0; i < 8; ++i) v[i] = __builtin_nontemporal_load((const f32x4*)(w.W + (size_t)(w.k0 + 8 * wave + i) * w.N + w.n0 + 4 * lane));
}
__device__ __forceinline__ void prologue(LAS unsigned char* lds, int tid, int lane, int wave) {
    KARGS; const int G = gridDim.x;
    {
        f32x4 va[8], vb[8]; WTile wa, wb; int it = blockIdx.x;
        if (it < N_WTILES) { wa = decode_tile(it); tile_load(wa, lane, wave, va); }
        if (it + G < N_WTILES) { wb = decode_tile(it + G); tile_load(wb, lane, wave, vb); }
#define WT_PROCESS(W, V, NEXT) do { \
            _Pragma("unroll") for (int i = 0; i < 8; ++i) { const int kr = 8 * wave + i; const float sc_ = W.ks ? W.ks[W.k0 + kr] : 1.0f; \
                u32x2 p; p.x = pk2(V[i][0] * sc_, V[i][1] * sc_); p.y = pk2(V[i][2] * sc_, V[i][3] * sc_); *(LAS u32x2*)(lds + kr * TPITCH + lane * 8) = p; } \
            __syncthreads(); \
            const WTile wc_ = W; const int itn_ = (NEXT); \
            if (itn_ < N_WTILES) { W = decode_tile(itn_); tile_load(W, lane, wave, V); } \
            _Pragma("unroll") for (int q = 0; q < 4; ++q) { \
                const int n = q * 64 + (tid >> 3), kc = tid & 7; unsigned short e[8]; \
                _Pragma("unroll") for (int jj = 0; jj < 8; ++jj) e[jj] = *(const LAS unsigned short*)(lds + (kc * 8 + jj) * TPITCH + n * 2); \
                u32x4 o; o.x = e[0] | ((unsigned)e[1] << 16); o.y = e[2] | ((unsigned)e[3] << 16); o.z = e[4] | ((unsigned)e[5] << 16); o.w = e[6] | ((unsigned)e[7] << 16); \
                const int s_ = wc_.n0 + n; int dr = s_; \
                if (wc_.mode == 1) dr = (s_ < 2048) ? (256 * (s_ >> 7) + (s_ & 127)) : (256 * ((s_ - 2048) >> 7) + 128 + (s_ & 127)); \
                *(u32x4*)(wc_.Wt + (size_t)dr * wc_.K + wc_.k0 + kc * 8) = o; } \
            __syncthreads(); } while (0)
        for (; it < N_WTILES; it += 2 * G) {
            WT_PROCESS(wa, va, it + 2 * G);
            if (it + G < N_WTILES) WT_PROCESS(wb, vb, it + 3 * G);
        }
#undef WT_PROCESS
    }
    const int gw = blockIdx.x * NWAVES + wave, NGW = G * NWAVES;
    {
        float* X = (float*)(a.ws + WS_X); bf16_t* XB = (bf16_t*)(a.ws + WS_XB); float* rsp = (float*)(a.ws + WS_RSP);
        for (int t = gw; t < T; t += NGW) {
            const float* src = t < TP ? a.in[I_XP] + (size_t)t * D : a.in[I_XS] + (size_t)(t - TP) * D; float ss = 0.f;
#pragma unroll
            for (int jj = 0; jj < 8; ++jj) { const int c = 4 * (lane + 64 * jj); const f32x4 x = *(const f32x4*)(src + c);
                *(f32x4*)(X + (size_t)t * D + c) = x; u32x2 p; p.x = pk2(x[0], x[1]); p.y = pk2(x[2], x[3]); *(u32x2*)(XB + (size_t)t * D + c) = p;
                ss += (x[0] * x[0] + x[1] * x[1]) + (x[2] * x[2] + x[3] * x[3]); }
            ss = wave_sum(ss);
            if (lane < 32) rsp[(size_t)t * 64 + lane] = lane == 0 ? ss : 0.f;
        }
    }
    {
        float* cosT = (float*)(a.ws + WS_COS); float* sinT = (float*)(a.ws + WS_SIN);
        for (int e = blockIdx.x * NTHREADS + tid; e < 8192 * 128; e += G * NTHREADS) {
            const int pos = e >> 7, d = e & 127; const float inv = exp2f(-(float)d * (13.287712379549449f / 128.0f)); const float ang = (float)pos * inv;
            float s, c; sincosf(ang, &s, &c); cosT[e] = c; sinT[e] = s;
        }
    }
}

constexpr int RS_D = 8, RS_PITCH = 144, RS_TILE = 64 * RS_PITCH, RS_STAGE = 2 * RS_TILE;
__device__ __forceinline__ void ret_scan_phase(int j, LAS unsigned char* lds, int tid, int lane, int wave) { KARGS;
    const int fr = lane & 15, fq = lane >> 4;
    const bf16_t* KT = (const bf16_t*)(a.ws + WS_KT); const bf16_t* VT = (const bf16_t*)(a.ws + WS_VT); bf16_t* ST = (bf16_t*)(a.ws + WS_ST);
    constexpr size_t KCS = (size_t)8 * 256 * 64, VCS = (size_t)8 * 512 * 64;
    for (int item = blockIdx.x; item < 256; item += gridDim.x) {
        const int h = item & 7, dq = (item >> 3) & 3, eo = item >> 5;
        const float g64 = exp2f(64.0f * log2gamma(h));
        const int lrow = tid >> 3, lpc = tid & 7;
        const bf16_t* kg = KT + ((size_t)h * 256 + 64 * dq + lrow) * 64 + lpc * 8;
        const bf16_t* vg = VT + ((size_t)h * 512 + 64 * eo + lrow) * 64 + lpc * 8;
        const int lw = lrow * RS_PITCH + lpc * 16;
        const int dtw = wave & 3, ep = wave >> 2;
        const int ka_off = (16 * dtw + fr) * RS_PITCH + 16 * fq, vb_off = RS_TILE + (32 * ep + fr) * RS_PITCH + 16 * fq;
        const int d0 = 64 * dq + 16 * dtw + 4 * fq, e0 = 64 * eo + 32 * ep + fr;
        float sst[8][8];
#pragma unroll
        for (int b = 0; b < 8; ++b) { const float* sp = a.in[I_SRET] + ((size_t)((j * 8 + b) * 8 + h) * 256 + d0) * 512 + e0;
#pragma unroll
            for (int r = 0; r < 4; ++r) { sst[b][r] = sp[(size_t)r * 512]; sst[b][4 + r] = sp[(size_t)r * 512 + 16]; } }
        u32x4 kr[RS_D], vr[RS_D];
#pragma unroll
        for (int s = 0; s < RS_D; ++s) { kr[s] = *(const u32x4*)(kg + s * KCS); vr[s] = *(const u32x4*)(vg + s * VCS); }
        *(LAS u32x4*)(lds + lw) = kr[0]; *(LAS u32x4*)(lds + RS_TILE + lw) = vr[0];
        kr[0] = *(const u32x4*)(kg + RS_D * KCS); vr[0] = *(const u32x4*)(vg + RS_D * VCS);
        __syncthreads();
        f32x4 acc0 = {0.f, 0.f, 0.f, 0.f}, acc1 = {0.f, 0.f, 0.f, 0.f};
#pragma unroll 1
        for (int c0 = 0; c0 < NCH; c0 += RS_D) {
            const bool samp = c0 >= NPC;
#pragma unroll
            for (int s = 0; s < RS_D; ++s) {
                const int c = c0 + s;
                { constexpr int dummy = 0; (void)dummy; const int sl = (s + 1) % RS_D; LAS unsigned char* st = lds + ((c + 1) & 1) * RS_STAGE;
                  *(LAS u32x4*)(st + lw) = kr[sl]; *(LAS u32x4*)(st + RS_TILE + lw) = vr[sl];
                  int cn = c + 1 + RS_D; cn = cn < NCH ? cn : NCH - 1;
                  kr[sl] = *(const u32x4*)(kg + cn * KCS); vr[sl] = *(const u32x4*)(vg + cn * VCS); }
                if (samp) {
#pragma unroll
                    for (int r = 0; r < 4; ++r) { acc0[r] = sst[s][r]; acc1[r] = sst[s][4 + r]; }
                }
                if (samp ? (s > 0) : (s & 1)) { const int sbp = samp ? ((s - 1) & 1) : (((s - 1) >> 1) & 1);
                  const u32x4 vv = *(const LAS u32x4*)(lds + 2 * RS_STAGE + sbp * RS_TILE + (tid >> 3) * RS_PITCH + (tid & 7) * 16);
                  *(u32x4*)(ST + ((size_t)((c - 1) * 8 + h) * 512 + 64 * eo + (tid >> 3)) * 256 + 64 * dq + (tid & 7) * 8) = vv; }
                if (samp || !(s & 1)) { const int sb = samp ? (s & 1) : ((s >> 1) & 1);
                  LAS unsigned char* sp = lds + 2 * RS_STAGE + sb * RS_TILE + (32 * ep + fr) * RS_PITCH + (16 * dtw + 4 * fq) * 2;
                  u32x2 p; p.x = pk2(acc0[0], acc0[1]); p.y = pk2(acc0[2], acc0[3]); *(LAS u32x2*)sp = p;
                  p.x = pk2(acc1[0], acc1[1]); p.y = pk2(acc1[2], acc1[3]); *(LAS u32x2*)(sp + 16 * RS_PITCH) = p; }
                acc0 *= g64; acc1 *= g64;
                { const LAS unsigned char* st = lds + (c & 1) * RS_STAGE;
#pragma unroll
                  for (int ks = 0; ks < 2; ++ks) { const bf16x8 kf = *(const LAS bf16x8*)(st + ka_off + 64 * ks), v0 = *(const LAS bf16x8*)(st + vb_off + 64 * ks), v1 = *(const LAS bf16x8*)(st + vb_off + 16 * RS_PITCH + 64 * ks);
                      acc0 = __builtin_amdgcn_mfma_f32_16x16x32_bf16(kf, v0, acc0, 0, 0, 0); acc1 = __builtin_amdgcn_mfma_f32_16x16x32_bf16(kf, v1, acc1, 0, 0, 0); } }
                if (samp || c == NPC - 1) {
                    float* op = samp ? a.out + O_RETS + ((size_t)((j * 8 + s) * 8 + h) * 256 + d0) * 512 + e0 : a.out + O_RETP + ((size_t)(j * 8 + h) * 256 + d0) * 512 + e0;
#pragma unroll
                    for (int r = 0; r < 4; ++r) { op[(size_t)r * 512] = acc0[r]; op[(size_t)r * 512 + 16] = acc1[r]; }
                }
                __syncthreads();
            }
        }
        { const u32x4 vv = *(const LAS u32x4*)(lds + 2 * RS_STAGE + 1 * RS_TILE + (tid >> 3) * RS_PITCH + (tid & 7) * 16);
          *(u32x4*)(ST + ((size_t)((NCH - 1) * 8 + h) * 512 + 64 * eo + (tid >> 3)) * 256 + 64 * dq + (tid & 7) * 8) = vv; }
        __syncthreads();
    }
}

constexpr int QPITCH = 528, PPITCH = 144, R3_P = 33792, R3_P2 = 43008, R3_RED = 52224;
__device__ __forceinline__ void ret_out_phase(int j, LAS unsigned char* lds, int tid, int lane, int wave, int dry) { KARGS;
    const int fr = lane & 15, fq = lane >> 4;
    const bf16_t* Q = (const bf16_t*)(a.ws + WS_Q); const bf16_t* K = (const bf16_t*)(a.ws + WS_K); const bf16_t* VT = (const bf16_t*)(a.ws + WS_VT);
    const bf16_t* ST = (const bf16_t*)(a.ws + WS_ST); bf16_t* GO = (bf16_t*)(a.ws + WS_G); const float* gn = a.in[I_GN] + (size_t)j * NVD;
    LAS unsigned char* Ql = lds; LAS unsigned char* Pl = lds + R3_P; LAS unsigned char* Pl2 = lds + R3_P2; LAS float* red = (LAS float*)(lds + R3_RED);
    u32x4 qn[4];
    if ((int)blockIdx.x < NCH * RH) { const int c_ = blockIdx.x >> 3, h_ = blockIdx.x & 7;
#pragma unroll
        for (int i = 0; i < 4; ++i) { const int idx = tid + NTHREADS * i, row = idx >> 5, ch = idx & 31; qn[i] = *(const u32x4*)(Q + (size_t)(c_ * 64 + row) * 2048 + h_ * 256 + ch * 8); } }
    for (int unit = blockIdx.x; unit < NCH * RH; unit += gridDim.x) {
        const int c = unit >> 3, h = unit & 7, t0 = c * 64; const float l2g = log2gamma(h);
        const bool odd = (c < NPC) && (c & 1); const int cs = odd ? c - 1 : c;
#pragma unroll
        for (int i = 0; i < 4; ++i) { const int idx = tid + NTHREADS * i, row = idx >> 5, ch = idx & 31; *(LAS u32x4*)(Ql + row * QPITCH + ch * 16) = qn[i]; }
        const bf16_t* kp = K + (size_t)(t0 + 16 * (wave & 3) + fr) * 2048 + h * 256 + 8 * fq;
        bf16x8 kfa[8];
#pragma unroll
        for (int ks = 0; ks < 8; ++ks) kfa[ks] = *(const bf16x8*)(kp + 32 * ks);
        __syncthreads();
        {
            const int mt = wave & 3, lt0 = (wave >> 2) * 2;
            f32x4 sc[2] = {{0.f, 0.f, 0.f, 0.f}, {0.f, 0.f, 0.f, 0.f}};
#pragma unroll
            for (int ks = 0; ks < 8; ++ks) { const bf16x8 kf = kfa[ks];
#pragma unroll
                for (int i = 0; i < 2; ++i) { const bf16x8 qf = *(const LAS bf16x8*)(Ql + (16 * (lt0 + i) + fr) * QPITCH + (32 * ks + 8 * fq) * 2); sc[i] = __builtin_amdgcn_mfma_f32_16x16x32_bf16(kf, qf, sc[i], 0, 0, 0); } }
#pragma unroll
            for (int i = 0; i < 2; ++i) { const int l = 16 * (lt0 + i) + fr, m0 = 16 * mt + 4 * fq; float p[4];
#pragma unroll
                for (int r = 0; r < 4; ++r) { const int dist = l - (m0 + r); p[r] = sc[i][r] * exp2f((float)(dist < 0 ? -dist : dist) * l2g); }
                u32x2 w; w.x = pk2(p[0], p[1]); w.y = pk2(p[2], p[3]); *(LAS u32x2*)(Pl + l * PPITCH + m0 * 2) = w; }
            if (odd) {
                f32x4 s2[2] = {{0.f, 0.f, 0.f, 0.f}, {0.f, 0.f, 0.f, 0.f}};
                const bf16_t* kp2 = kp - (size_t)64 * 2048;
#pragma unroll
                for (int ks = 0; ks < 8; ++ks) { const bf16x8 kf = *(const bf16x8*)(kp2 + 32 * ks);
#pragma unroll
                    for (int i = 0; i < 2; ++i) { const bf16x8 qf = *(const LAS bf16x8*)(Ql + (16 * (lt0 + i) + fr) * QPITCH + (32 * ks + 8 * fq) * 2); s2[i] = __builtin_amdgcn_mfma_f32_16x16x32_bf16(kf, qf, s2[i], 0, 0, 0); } }
#pragma unroll
                for (int i = 0; i < 2; ++i) { const int l = 16 * (lt0 + i) + fr, m0 = 16 * mt + 4 * fq; float p[4];
#pragma unroll
                    for (int r = 0; r < 4; ++r) p[r] = s2[i][r] * exp2f((float)(64 + l - (m0 + r)) * l2g);
                    u32x2 w; w.x = pk2(p[0], p[1]); w.y = pk2(p[2], p[3]); *(LAS u32x2*)(Pl2 + l * PPITCH + m0 * 2) = w; }
            }
        }
        const bf16_t* sp = ST + ((size_t)(cs * 8 + h) * 512 + 64 * wave + fr) * 256 + 8 * fq;
        bf16x8 af[2][4];
#pragma unroll
        for (int et = 0; et < 4; ++et) af[0][et] = *(const bf16x8*)(sp + (size_t)et * 16 * 256);
        __syncthreads();
        f32x4 acc[4][4];
#pragma unroll
        for (int et = 0; et < 4; ++et)
#pragma unroll
            for (int lt = 0; lt < 4; ++lt) acc[et][lt] = (f32x4){0.f, 0.f, 0.f, 0.f};
        {
#pragma unroll
            for (int ks = 0; ks < 8; ++ks) {
                if (ks < 7) {
#pragma unroll
                    for (int et = 0; et < 4; ++et) af[(ks + 1) & 1][et] = *(const bf16x8*)(sp + (size_t)et * 16 * 256 + 32 * (ks + 1));
                }
                bf16x8 qf[4];
#pragma unroll
                for (int lt = 0; lt < 4; ++lt) qf[lt] = *(const LAS bf16x8*)(Ql + (16 * lt + fr) * QPITCH + (32 * ks + 8 * fq) * 2);
#pragma unroll
                for (int et = 0; et < 4; ++et)
#pragma unroll
                    for (int lt = 0; lt < 4; ++lt) acc[et][lt] = __builtin_amdgcn_mfma_f32_16x16x32_bf16(af[ks & 1][et], qf[lt], acc[et][lt], 0, 0, 0);
            }
        }
#pragma unroll
        for (int lt = 0; lt < 4; ++lt) { const float cr = exp2f((float)(16 * lt + fr + 1 + (odd ? 64 : 0)) * l2g);
#pragma unroll
            for (int et = 0; et < 4; ++et) acc[et][lt] *= cr; }
        {
            const bf16_t* vp = VT + ((size_t)(c * 8 + h) * 512 + 64 * wave + fr) * 64 + 8 * fq;
#pragma unroll
            for (int ks = 0; ks < 2; ++ks) {
                bf16x8 vf[4], pf[4];
#pragma unroll
                for (int et = 0; et < 4; ++et) vf[et] = *(const bf16x8*)(vp + (size_t)et * 16 * 64 + 32 * ks);
#pragma unroll
                for (int lt = 0; lt < 4; ++lt) pf[lt] = *(const LAS bf16x8*)(Pl + (16 * lt + fr) * PPITCH + (32 * ks + 8 * fq) * 2);
#pragma unroll
                for (int et = 0; et < 4; ++et)
#pragma unroll
                    for (int lt = 0; lt < 4; ++lt) acc[et][lt] = __builtin_amdgcn_mfma_f32_16x16x32_bf16(vf[et], pf[lt], acc[et][lt], 0, 0, 0);
            }
            if (odd) {
                const bf16_t* vp2 = vp - (size_t)8 * 512 * 64;
#pragma unroll
                for (int ks = 0; ks < 2; ++ks) {
                    bf16x8 vf[4], pf[4];
#pragma unroll
                    for (int et = 0; et < 4; ++et) vf[et] = *(const bf16x8*)(vp2 + (size_t)et * 16 * 64 + 32 * ks);
#pragma unroll
                    for (int lt = 0; lt < 4; ++lt) pf[lt] = *(const LAS bf16x8*)(Pl2 + (16 * lt + fr) * PPITCH + (32 * ks + 8 * fq) * 2);
#pragma unroll
                    for (int et = 0; et < 4; ++et)
#pragma unroll
                        for (int lt = 0; lt < 4; ++lt) acc[et][lt] = __builtin_amdgcn_mfma_f32_16x16x32_bf16(vf[et], pf[lt], acc[et][lt], 0, 0, 0);
                }
            }
        }
        { const int un = unit + (int)gridDim.x;
          if (un < NCH * RH) { const int c_ = un >> 3, h_ = un & 7;
#pragma unroll
              for (int i = 0; i < 4; ++i) { const int idx = tid + NTHREADS * i, row = idx >> 5, ch = idx & 31; qn[i] = *(const u32x4*)(Q + (size_t)(c_ * 64 + row) * 2048 + h_ * 256 + ch * 8); } } }
        u32x2 gpre[4][4]; f32x4 gvp[4];
#pragma unroll
        for (int et = 0; et < 4; ++et) { const int e = 64 * wave + 16 * et + 4 * fq; gvp[et] = *(const f32x4*)(gn + h * 512 + e);
#pragma unroll
            for (int lt = 0; lt < 4; ++lt) gpre[et][lt] = *(const u32x2*)(GO + (size_t)(t0 + 16 * lt + fr) * NVD + h * 512 + e); }
        float mu[4], rstd[4];
#pragma unroll
        for (int lt = 0; lt < 4; ++lt) { float s = 0.f;
#pragma unroll
            for (int et = 0; et < 4; ++et) s += (acc[et][lt][0] + acc[et][lt][1]) + (acc[et][lt][2] + acc[et][lt][3]);
            s += __shfl_xor(s, 16); s += __shfl_xor(s, 32);
            if (fq == 0) red[wave * 64 + 16 * lt + fr] = s; }
        __syncthreads();
#pragma unroll
        for (int lt = 0; lt < 4; ++lt) { float s = 0.f;
#pragma unroll
            for (int w = 0; w < 8; ++w) s += red[w * 64 + 16 * lt + fr];
            mu[lt] = s * (1.0f / 512.0f); }
#pragma unroll
        for (int lt = 0; lt < 4; ++lt) { float q = 0.f;
#pragma unroll
            for (int et = 0; et < 4; ++et) { const f32x4 dd = acc[et][lt] - mu[lt]; q += (dd[0] * dd[0] + dd[1] * dd[1]) + (dd[2] * dd[2] + dd[3] * dd[3]); }
            q += __shfl_xor(q, 16); q += __shfl_xor(q, 32);
            if (fq == 0) red[512 + wave * 64 + 16 * lt + fr] = q; }
        __syncthreads();
#pragma unroll
        for (int lt = 0; lt < 4; ++lt) { float q = 0.f;
#pragma unroll
            for (int w = 0; w < 8; ++w) q += red[512 + w * 64 + 16 * lt + fr];
            rstd[lt] = rsqrtf(q * (1.0f / 512.0f) + EPS); }
#pragma unroll
        for (int et = 0; et < 4; ++et) { const int e = 64 * wave + 16 * et + 4 * fq; const f32x4 gv = gvp[et];
#pragma unroll
            for (int lt = 0; lt < 4; ++lt) { bf16_t* gp = GO + (size_t)(t0 + 16 * lt + fr) * NVD + h * 512 + e; const u32x2 gw2 = gpre[et][lt];
                const f32x4 o = (acc[et][lt] - mu[lt]) * rstd[lt] * gv;
                u32x2 w; w.x = pk2(o[0] * bflo(gw2.x), o[1] * bfhi(gw2.x)); w.y = pk2(o[2] * bflo(gw2.y), o[3] * bfhi(gw2.y)); if (!dry) *(u32x2*)gp = w; } }
    }
}
constexpr int SSM_WLDS = 17664;
#define CBAR() asm volatile("s_waitcnt lgkmcnt(0)" ::: "memory")
template <int PASS> __device__ __forceinline__ void ssm_phase(int j, LAS unsigned char* lds, int lane, int wave) { KARGS;
    const int fr = lane & 15, fq = lane >> 4; const int gw = blockIdx.x * NWAVES + wave, NGW = gridDim.x * NWAVES;
    const int li = 2 * j + 1;
    const float* X = (const float*)(a.ws + WS_X); const float* rsp = (const float*)(a.ws + WS_RSP) + (size_t)(2 * li) * T * 64; float* Fb = (float*)(a.ws + WS_F);
    bf16_t* GL = (bf16_t*)(a.ws + WS_GL);
    LAS unsigned char* hL = lds + wave * SSM_WLDS; LAS unsigned char* buL = hL + 8192; LAS float* rsL = (LAS float*)(hL + 16384); LAS f32x4* cfL = (LAS f32x4*)(hL + 16640);
    const float* gmix = a.in[I_NMIX] + (size_t)li * D;
    for (int task = gw; task < 2048; task += NGW) {
        const int g = (((task >> 3) & 31) << 2) | (task & 3), rr_ = 2 * (task >> 8) + ((task >> 2) & 1), c_begin = 8 * rr_, sb_ = rr_ >> 1, nchunk = (rr_ & 1) ? 8 : 9;
        const int p = lane;
        const float dt = expf(a.in[I_LDT][j * 128 + g]);
        const float are = a.in[I_ARE][(size_t)(j * 128 + g) * 64 + p], aim = a.in[I_AIM][(size_t)(j * 128 + g) * 64 + p];
        const float xx = are * dt, yy = aim * dt, ex = expf(xx); float sy, cy; sincosf(yy, &sy, &cy);
        const float abr = ex * cy, abi = ex * sy;
        { const float sh = sinf(0.5f * yy); const float m1r = expm1f(xx) * cy - 2.0f * sh * sh, m1i = abi;
          const float inv = 1.0f / (are * are + aim * aim); const float cr = (m1r * are + m1i * aim) * inv, ci = (m1i * are - m1r * aim) * inv;
          cfL[p] = (f32x4){cr, ci, abr, abi}; }
        CBAR();
        float hr = 0.f, hi = 0.f;
        if (PASS == 3) {
            {
                float pr = abr, pi = abi;
#pragma unroll
                for (int s = 0; s < 6; ++s) { const float nr = pr * pr - pi * pi, ni = 2.0f * pr * pi; pr = nr; pi = ni; }
                f32x2 fn[8];
#pragma unroll
                for (int q = 0; q < 8; ++q) fn[q] = *(const f32x2*)(Fb + ((size_t)(q * 128 + g) * 64 + p) * 2);
                for (int cp = 0; cp < c_begin; cp += 8) { f32x2 f[8];
#pragma unroll
                    for (int q = 0; q < 8; ++q) f[q] = fn[q];
                    const int cq = cp + 8 < NPC ? cp + 8 : cp;
#pragma unroll
                    for (int q = 0; q < 8; ++q) fn[q] = *(const f32x2*)(Fb + ((size_t)((cq + q) * 128 + g) * 64 + p) * 2);
#pragma unroll
                    for (int q = 0; q < 8; ++q) { const float nr = pr * hr - pi * hi + f[q].x, ni = pr * hi + pi * hr + f[q].y; hr = nr; hi = ni; } }
            }
        }
        bf16x8 bfr[4], bfi[4];
#pragma unroll
        for (int pt = 0; pt < 4; ++pt) {
            const bf16x8 z = {0, 0, 0, 0, 0, 0, 0, 0}; bfr[pt] = z; bfi[pt] = z;
            if (fq < 2) {
                const int pp = 16 * pt + fr; const f32x4 cf4 = cfL[pp]; const float cr = cf4[0], ci = cf4[1];
                const float* br = a.in[I_BRE] + ((size_t)(j * 128 + g) * 64 + pp) * 16 + 8 * fq; const float* bi = a.in[I_BIM] + ((size_t)(j * 128 + g) * 64 + pp) * 16 + 8 * fq;
                const f32x4 r0 = *(const f32x4*)br, r1 = *(const f32x4*)(br + 4), i0 = *(const f32x4*)bi, i1 = *(const f32x4*)(bi + 4);
                const f32x4 g0 = *(const f32x4*)(gmix + 16 * g + 8 * fq), g1 = *(const f32x4*)(gmix + 16 * g + 8 * fq + 4);
                const f32x4 re0 = (r0 * cr - i0 * ci) * g0, re1 = (r1 * cr - i1 * ci) * g1, im0 = (i0 * cr + r0 * ci) * g0, im1 = (i1 * cr + r1 * ci) * g1;
                u32x4 w; w.x = pk2(re0[0], re0[1]); w.y = pk2(re0[2], re0[3]); w.z = pk2(re1[0], re1[1]); w.w = pk2(re1[2], re1[3]); bfr[pt] = __builtin_bit_cast(bf16x8, w);
                w.x = pk2(im0[0], im0[1]); w.y = pk2(im0[2], im0[3]); w.z = pk2(im1[0], im1[1]); w.w = pk2(im1[2], im1[3]); bfi[pt] = __builtin_bit_cast(bf16x8, w);
            }
        }
        bf16x8 cf[4]; float dd = 0.f;
        if (PASS == 3) {
            const float* cre = a.in[I_CRE] + ((size_t)(j * 128 + g) * 16 + fr) * 64 + 4 * fq; const float* cim = a.in[I_CIM] + ((size_t)(j * 128 + g) * 16 + fr) * 64 + 4 * fq;
#pragma unroll
            for (int ks = 0; ks < 4; ++ks) { const f32x4 vr = *(const f32x4*)(cre + 16 * ks), vi = *(const f32x4*)(cim + 16 * ks);
                u32x4 w; w.x = pk2(vr[0], -vi[0]); w.y = pk2(vr[1], -vi[1]); w.z = pk2(vr[2], -vi[2]); w.w = pk2(vr[3], -vi[3]); cf[ks] = __builtin_bit_cast(bf16x8, w); }
            dd = a.in[I_SD][(size_t)j * D + 16 * g + fr] * gmix[16 * g + fr];
        }
#pragma unroll 1
        for (int kc = 0; kc < nchunk; ++kc) {
            int c = c_begin + kc;
            if (kc == 8) {
                c = NPC + sb_;
                if (PASS == 3) { hr = a.in[I_SRE][((size_t)(j * 8 + sb_) * 128 + g) * 64 + p]; hi = a.in[I_SIM][((size_t)(j * 8 + sb_) * 128 + g) * 64 + p]; }
            }
            if (PASS == 1) { hr = 0.f; hi = 0.f; }
            { const int t = 64 * c + lane; float ssq = 0.f;
#pragma unroll
              for (int q = 0; q < 8; ++q) { const f32x4 v = *(const f32x4*)(rsp + (size_t)t * 64 + 4 * q); ssq += (v[0] + v[1]) + (v[2] + v[3]); }
              rsL[lane] = rsqrtf(ssq * (1.0f / D) + EPS); }
            CBAR();
#pragma unroll 1
            for (int half = 0; half < 2; ++half) {
#pragma unroll
                for (int lt = 0; lt < 2; ++lt) {
                    bf16x8 uf = {0, 0, 0, 0, 0, 0, 0, 0};
                    if (fq < 2) { const int l = 32 * half + 16 * lt + fr; const float rs = rsL[l]; const float* xp = X + (size_t)(64 * c + l) * D + 16 * g + 8 * fq;
                        const f32x4 x0 = *(const f32x4*)xp * rs, x1 = *(const f32x4*)(xp + 4) * rs;
                        u32x4 w; w.x = pk2(x0[0], x0[1]); w.y = pk2(x0[2], x0[3]); w.z = pk2(x1[0], x1[1]); w.w = pk2(x1[2], x1[3]); uf = __builtin_bit_cast(bf16x8, w); }
                    f32x4 dre[4], dim[4];
#pragma unroll
                    for (int pt = 0; pt < 4; ++pt) { const f32x4 z4 = {0.f, 0.f, 0.f, 0.f};
                        dre[pt] = __builtin_amdgcn_mfma_f32_16x16x32_bf16(uf, bfr[pt], z4, 0, 0, 0); dim[pt] = __builtin_amdgcn_mfma_f32_16x16x32_bf16(uf, bfi[pt], z4, 0, 0, 0); }
                    asm volatile("s_nop 15\n\ts_nop 15" : "+v"(dre[0]), "+v"(dre[1]), "+v"(dre[2]), "+v"(dre[3]), "+v"(dim[0]), "+v"(dim[1]), "+v"(dim[2]), "+v"(dim[3]));
#pragma unroll
                    for (int pt = 0; pt < 4; ++pt)
#pragma unroll
                        for (int r = 0; r < 4; ++r) *(LAS unsigned*)(buL + (16 * lt + 4 * fq + r) * 256 + 4 * (16 * pt + fr)) = pk2(dre[pt][r], dim[pt][r]);
                }
                CBAR();
#pragma unroll 1
                for (int l8 = 0; l8 < 32; l8 += 8) {
                    unsigned w[8];
#pragma unroll
                    for (int q = 0; q < 8; ++q) w[q] = *(const LAS unsigned*)(buL + (l8 + q) * 256 + 4 * p);
#pragma unroll
                    for (int q = 0; q < 8; ++q) {
                        const float nr = abr * hr - abi * hi + bflo(w[q]), ni = abr * hi + abi * hr + bfhi(w[q]); hr = nr; hi = ni;
                        if (PASS == 3) *(LAS unsigned*)(hL + (l8 + q) * 256 + ((((p >> 2) ^ ((l8 + q) & 15))) << 4) + (p & 3) * 4) = pk2(hr, hi);
                    }
                }
                CBAR();
                if (PASS == 3) {
#pragma unroll
                    for (int lt = 0; lt < 2; ++lt) {
                        f32x4 y = {0.f, 0.f, 0.f, 0.f};
#pragma unroll
                        for (int ks = 0; ks < 4; ++ks) { const bf16x8 hf = *(const LAS bf16x8*)(hL + (16 * lt + fr) * 256 + (((4 * ks + fq) ^ fr) << 4)); y = __builtin_amdgcn_mfma_f32_16x16x32_bf16(hf, cf[ks], y, 0, 0, 0); }
                        asm volatile("s_nop 15\n\ts_nop 15" : "+v"(y));
                        const int ch = 16 * g + fr;
#pragma unroll
                        for (int r = 0; r < 4; ++r) { const int l = 32 * half + 16 * lt + 4 * fq + r; const size_t t = (size_t)(64 * c + l);
                            const float v = y[r] + dd * X[t * D + ch] * rsL[l];
                            GL[t * D + ch] = (bf16_t)f2bf(gelu_tanh(v)); }
                    }
                    CBAR();
                }
            }
            if (PASS == 1) { *(f32x2*)(Fb + ((size_t)(c * 128 + g) * 64 + p) * 2) = (f32x2){hr, hi}; }
            else {
                if (c == NPC - 1) { a.out[O_REP + (size_t)(j * 128 + g) * 64 + p] = hr; a.out[O_IMP + (size_t)(j * 128 + g) * 64 + p] = hi; }
                else if (c >= NPC) { const int b = c - NPC; a.out[O_RES + ((size_t)(j * 8 + b) * 128 + g) * 64 + p] = hr; a.out[O_IMS + ((size_t)(j * 8 + b) * 128 + g) * 64 + p] = hi; }
            }
            CBAR();
        }
    }
}

__device__ __forceinline__ void unpack8(const u32x4 w, float (&f)[8]) { f[0] = bflo(w.x); f[1] = bfhi(w.x); f[2] = bflo(w.y); f[3] = bfhi(w.y); f[4] = bflo(w.z); f[5] = bfhi(w.z); f[6] = bflo(w.w); f[7] = bfhi(w.w); }
__device__ __forceinline__ void conv_phase(int li, int tid) { KARGS;
    const bf16_t* A_ = (const bf16_t*)(a.ws + WS_A); const bf16_t* B_ = (const bf16_t*)(a.ws + WS_B); bf16_t* HM = (bf16_t*)(a.ws + WS_HM);
    const int col = tid * 8;
    float w0[8], w1[8], w2[8], cb[8];
    { const float* cw = a.in[I_CW] + (size_t)li * 3 * FF + col; const float* cbp = a.in[I_CB] + (size_t)li * FF + col;
#pragma unroll
      for (int e = 0; e < 8; ++e) { w0[e] = cw[e]; w1[e] = cw[FF + e]; w2[e] = cw[2 * FF + e]; cb[e] = cbp[e]; } }
#define CONV_LOAD(blk_, AR, BR) do { const int t0_ = (blk_) * 8, th_ = t0_ >= 2 ? t0_ - 2 : 0; \
        AR[0] = *(const u32x4*)(A_ + (size_t)th_ * FF + col); AR[1] = *(const u32x4*)(A_ + (size_t)(th_ + 1) * FF + col); \
        _Pragma("unroll") for (int r_ = 0; r_ < 8; ++r_) { AR[2 + r_] = *(const u32x4*)(A_ + (size_t)(t0_ + r_) * FF + col); BR[r_] = *(const u32x4*)(B_ + (size_t)(t0_ + r_) * FF + col); } } while (0)
#define CONV_COMPUTE(blk_, AR, BR) do { const int t0 = (blk_) * 8; float am2[8], am1[8]; \
        if (t0 == 0) { _Pragma("unroll") for (int e = 0; e < 8; ++e) { am2[e] = 0.f; am1[e] = 0.f; } } \
        else if (t0 >= TP && (t0 & 63) == 0) { const float* cp = a.in[I_CACHE] + ((size_t)(li * 8 + ((t0 - TP) >> 6)) * 2) * FF + col; \
            _Pragma("unroll") for (int e = 0; e < 8; ++e) { am2[e] = cp[e]; am1[e] = cp[FF + e]; } } \
        else { unpack8(AR[0], am2); unpack8(AR[1], am1); } \
        _Pragma("unroll") for (int r = 0; r < 8; ++r) { float av[8], bv[8]; unpack8(AR[2 + r], av); unpack8(BR[r], bv); float o[8]; \
            _Pragma("unroll") for (int e = 0; e < 8; ++e) { const float v = cb[e] + w0[e] * am2[e] + w1[e] * am1[e] + w2[e] * av[e]; o[e] = silu_f(v) * bv[e]; am2[e] = am1[e]; am1[e] = av[e]; } \
            u32x4 w; w.x = pk2(o[0], o[1]); w.y = pk2(o[2], o[3]); w.z = pk2(o[4], o[5]); w.w = pk2(o[6], o[7]); \
            *(u32x4*)(HM + (size_t)(t0 + r) * FF + col) = w; } } while (0)
    constexpr int NB = T / 8; const int G = gridDim.x;
    u32x4 ar0[10], br0[8], ar1[10], br1[8];
    int blk = blockIdx.x;
    if (blk < NB) CONV_LOAD(blk, ar0, br0);
    for (; blk < NB; blk += 2 * G) {
        const int blk2 = blk + G;
        if (blk2 < NB) CONV_LOAD(blk2, ar1, br1);
        CONV_COMPUTE(blk, ar0, br0);
        if (blk2 < NB) { if (blk2 + G < NB) CONV_LOAD(blk2 + G, ar0, br0); CONV_COMPUTE(blk2, ar1, br1); }
    }
#undef CONV_LOAD
#undef CONV_COMPUTE
}

__device__ __forceinline__ void final_phase(int lane, int wave) { KARGS;
    const float* X = (const float*)(a.ws + WS_X); const float* rsp = (const float*)(a.ws + WS_RSP) + (size_t)8 * T * 64; const float* nf = a.in[I_NFIN];
    const int gw = blockIdx.x * NWAVES + wave, NGW = gridDim.x * NWAVES;
    for (int t = gw; t < T; t += NGW) { const float rs = rsqrtf(wave_sum(lane < 32 ? rsp[(size_t)t * 64 + lane] : 0.f) * (1.0f / D) + EPS);
#pragma unroll
        for (int jj = 0; jj < 8; ++jj) { const int c = 4 * (lane + 64 * jj); __builtin_nontemporal_store(*(const f32x4*)(X + (size_t)t * D + c) * rs * *(const f32x4*)(nf + c), (f32x4*)(a.out + O_Y + (size_t)t * D + c)); } }
}

__device__ __forceinline__ void samp_reduce(int nidx, int lane, int wave) { KARGS;
    float* X = (float*)(a.ws + WS_X); bf16_t* XB = (bf16_t*)(a.ws + WS_XB); float* rsp = (float*)(a.ws + WS_RSP) + (size_t)nidx * T * 64; const float* P = (const float*)(a.ws + WS_P);
    const int gw = blockIdx.x * NWAVES + wave, NGW = gridDim.x * NWAVES;
    for (int it = gw; it < TS * 4; it += NGW) {
        const int r = it >> 2, q = it & 3, t = TP + r, col = q * 512 + lane * 8;
        f32x4 x0 = *(const f32x4*)(X + (size_t)t * D + col), x1 = *(const f32x4*)(X + (size_t)t * D + col + 4);
#pragma unroll
        for (int sl = 0; sl < 16; ++sl) { const float* pp = P + ((size_t)sl * TS + r) * D + col; x0 += *(const f32x4*)pp; x1 += *(const f32x4*)(pp + 4); }
        *(f32x4*)(X + (size_t)t * D + col) = x0; *(f32x4*)(X + (size_t)t * D + col + 4) = x1; store8bf(XB + (size_t)t * D + col, x0, x1);
        float ss = (x0[0] * x0[0] + x0[1] * x0[1]) + (x0[2] * x0[2] + x0[3] * x0[3]) + (x1[0] * x1[0] + x1[1] * x1[1]) + (x1[2] * x1[2] + x1[3] * x1[3]);
        ss = wave_sum(ss);
        if (lane < 8) rsp[(size_t)t * 64 + q * 8 + lane] = lane == 0 ? ss : 0.f;
    }
}

constexpr int N_PHASES = 34;
__global__ void __launch_bounds__(NTHREADS, 2) mega_fwd(Args a_unused) {
    extern __shared__ __attribute__((aligned(16))) unsigned char lds_raw[];
    LAS unsigned char* lds = (LAS unsigned char*)lds_raw;
    cg::grid_group grid = cg::this_grid();
    volatile LAS unsigned* bst = (volatile LAS unsigned*)(lds + LDS_BYTES - 64);
    if (threadIdx.x < 16) bst[threadIdx.x] = 0u;
    __syncthreads();
    int ph = 0; int ph_lo, ph_hi, coop; { KARGS; ph_lo = a.ph_lo; ph_hi = a.ph_hi; coop = a.coop; if (coop && blockIdx.x == 0) { unsigned* bw = (unsigned*)(a.ws + WS_BAR); for (int i = threadIdx.x; i < 4096; i += NTHREADS) bw[i] = 0u; } }
#ifndef EN_MASK
#define EN_MASK 0xfff
#endif
#define EN(k) (((EN_MASK) >> (k)) & 1)
#ifndef PROBE_REP
#define PROBE_REP 0
#endif
#define RP(k) for (int rr = 0; rr <= ((PROBE_REP >> (k)) & 1); ++rr)
#define PH_RUN (ph >= ph_lo && ph < ph_hi)
#define PH_LOCALS int tid = threadIdx.x; asm volatile("" : "+v"(tid)); const int lane = tid & 63, wave = __builtin_amdgcn_readfirstlane(tid >> 6); int li = li_; asm volatile("" : "+s"(li)); const int j = li >> 1, G = gridDim.x; (void)lane; (void)wave; (void)j; (void)G
#define PH_END do { ++ph; if (coop && ph > ph_lo && ph < ph_hi) { \
        if (ph == 1) { asm volatile("s_waitcnt vmcnt(0) lgkmcnt(0)" ::: "memory"); grid.sync(); (void)xcd_barrier_post((unsigned*)(kargs()->ws + WS_BAR), bst); }     \
        else { XcdBarrier xb_; xb_.bar = (unsigned*)(kargs()->ws + WS_BAR); xb_.x = xb_xcc_id(); xb_.st = bst; xcd_barrier(xb_); } } } while (0)
#define GEMM_PTRS KARGS; bf16_t* XB = (bf16_t*)(a.ws + WS_XB); (void)XB
    { const int li_ = 0; if (PH_RUN && EN(0)) RP(0) { PH_LOCALS; prologue(lds, tid, lane, wave); } }
    PH_END;
#pragma unroll 1
    for (int li_ = 0; li_ < 4; ++li_) {
        if ((li_ & 1) == 0) {
            if (PH_RUN && EN(1)) RP(1) {
                PH_LOCALS; GEMM_PTRS;
                pg8::Gemm g{XB, (const bf16_t*)(a.ws + WS_WIN) + (size_t)j * NIN * 2048, T, NIN, 2048}; pg8::StaticOrder S; S.init(T, NIN, G, (int)blockIdx.x, 2048);
                EpiRetIn E{a.ws, li};
                pg8::gemm_phase<EpiRetIn, pg8::StaticOrder, true, true>(lds, g, S, E);
            }
            PH_END;
            if (PH_RUN && EN(2)) RP(2) { PH_LOCALS; ret_scan_phase(j, lds, tid, lane, wave); }
            PH_END;
            if (PH_RUN && EN(3)) RP(3) { PH_LOCALS; ret_out_phase(j, lds, tid, lane, wave, rr); }
            PH_END;
            if (PH_RUN && EN(4)) RP(4) {
                PH_LOCALS; GEMM_PTRS;
                pg8::Gemm g{(const bf16_t*)(a.ws + WS_G), (const bf16_t*)(a.ws + WS_WOUT) + (size_t)j * 2048 * 4096, T, 2048, 4096}; pg8::ResOrder S; S.init(G, (int)blockIdx.x);
                EpiRes<false> E{a.ws, 2 * li + 1, rr};
                pg8::gemm_phase<EpiRes<false>, pg8::ResOrder, true, true>(lds, g, S, E);
            }
            PH_END;
            if (PH_RUN && EN(4)) { PH_LOCALS; samp_reduce(2 * li + 1, lane, wave); }
            PH_END;
        } else {
            if (PH_RUN && EN(5)) RP(5) { PH_LOCALS; ssm_phase<1>(j, lds, lane, wave); }
            PH_END;
            if (PH_RUN && EN(6)) RP(6) { PH_LOCALS; ssm_phase<3>(j, lds, lane, wave); }
            PH_END;
            if (PH_RUN && EN(7)) RP(7) {
                PH_LOCALS; GEMM_PTRS;
                pg8::Gemm g{(const bf16_t*)(a.ws + WS_GL), (const bf16_t*)(a.ws + WS_WGLU) + (size_t)j * 4096 * 2048, T, 4096, 2048}; pg8::StaticOrder S; S.init(T, 4096, G, (int)blockIdx.x, 2048);
                EpiRes<true> E{a.ws, 2 * li + 1, rr};
                pg8::gemm_phase<EpiRes<true>, pg8::StaticOrder, true, true>(lds, g, S, E);
            }
            PH_END;
        }
        if (PH_RUN && EN(8)) RP(8) {
            PH_LOCALS; GEMM_PTRS;
            pg8::Gemm g{XB, (const bf16_t*)(a.ws + WS_WUP) + (size_t)li * 8192 * 2048, T, 8192, 2048}; pg8::StaticOrder S; S.init(T, 8192, G, (int)blockIdx.x, 2048);
            EpiUp E{a.ws, a.out, li};
            pg8::gemm_phase<EpiUp, pg8::StaticOrder, true, true>(lds, g, S, E);
        }
        PH_END;
        if (PH_RUN && EN(9)) RP(9) { PH_LOCALS; conv_phase(li, tid); }
        PH_END;
        if (PH_RUN && EN(10)) RP(10) {
            PH_LOCALS; GEMM_PTRS;
            pg8::Gemm g{(const bf16_t*)(a.ws + WS_HM), (const bf16_t*)(a.ws + WS_WDN) + (size_t)li * 2048 * 4096, T, 2048, 4096}; pg8::ResOrder S; S.init(G, (int)blockIdx.x);
            EpiRes<false> E{a.ws, 2 * li + 2, rr};
            pg8::gemm_phase<EpiRes<false>, pg8::ResOrder, true, true>(lds, g, S, E);
        }
        PH_END;
        if (PH_RUN && EN(10)) { PH_LOCALS; samp_reduce(2 * li + 2, lane, wave); }
        PH_END;
    }
    { const int li_ = 0; if (PH_RUN && EN(11)) RP(11) { PH_LOCALS; final_phase(lane, wave); } }
#undef PH_RUN
#undef PH_END
}

#ifndef MK_SINGLE
#define MK_SINGLE 1
#endif
extern "C" void kernel_launch(void* const* d_in, const int* in_sizes, int n_in, void* d_out, int out_size, void* d_ws, size_t ws_size, hipStream_t stream) {
    static int grid = 0;
    if (grid == 0) {
        if (n_in != 25 || (size_t)out_size != O_END || ws_size < WS_END) { fprintf(stderr, "kernel_launch: unexpected shapes: n_in %d out %d ws %zu (need %zu)\n", n_in, out_size, ws_size, (size_t)WS_END); grid = -1; return; }
        int dev = 0, cus = 0, per_cu = 0;
        (void)hipGetDevice(&dev); (void)hipDeviceGetAttribute(&cus, hipDeviceAttributeMultiprocessorCount, dev);
        if (hipFuncSetAttribute((const void*)mega_fwd, hipFuncAttributeMaxDynamicSharedMemorySize, LDS_BYTES) != hipSuccess) { fprintf(stderr, "kernel_launch: hipFuncSetAttribute failed\n"); grid = -1; return; }
        if (hipOccupancyMaxActiveBlocksPerMultiprocessor(&per_cu, (const void*)mega_fwd, NTHREADS, LDS_BYTES) != hipSuccess || per_cu < 1) { fprintf(stderr, "kernel_launch: occupancy query gave %d\n", per_cu); per_cu = 1; }
        (void)hipGetLastError();
        grid = cus * per_cu; if (grid > 256) grid = 256; if (grid < 1) grid = 1;
    }
    if (grid < 0) return;
    Args a{};
    for (int i = 0; i < 25; ++i) a.in[i] = (const float*)d_in[i];
    a.out = (float*)d_out; a.ws = (unsigned char*)d_ws;
#if MK_SINGLE
    a.ph_lo = 0; a.ph_hi = N_PHASES; a.coop = 1;
    void* args[] = {&a};
    hipError_t e = hipLaunchCooperativeKernel((const void*)mega_fwd, dim3(grid), dim3(NTHREADS), args, LDS_BYTES, stream);
    if (e != hipSuccess) fprintf(stderr, "kernel_launch: cooperative launch failed: %s (grid %d)\n", hipGetErrorString(e), grid);
#else
    for (int p = 0; p < N_PHASES; ++p) { a.ph_lo = p; a.ph_hi = p + 1; a.coop = 0; hipLaunchKernelGGL(mega_fwd, dim3(grid), dim3(NTHREADS), LDS_BYTES, stream, a); }
#endif
}
```
